# Optimizing an MI355X kernel written in HIP

```python
import math
import jax, jax.numpy as jnp
from jax import lax
import numpy as np

D_MODEL = 1024
BATCH = 4
SEQ = 4096
DEPTH = 1
DEC_BATCH = 128
DEC_SEQ = 4
PAST_LEN = 2048
PAGE_SIZE = 128

D_MIX = D_MODEL
D_LIN = D_MIX // 2
D_ATT = D_MIX - D_LIN
LIN_HEAD_DIM = 128
LIN_HEADS = D_LIN // LIN_HEAD_DIM
ATT_HEAD_DIM = 64
ATT_HEADS = D_ATT // ATT_HEAD_DIM
MOBA_BLOCK = 256
MOBA_TOPK = 3
MOBA_Q_ROWS = 128
HGRN_CHUNK = 64
N_BUCKETS = 32
MAX_DISTANCE = 1024
EPS = 1e-6
D_IN = 4 * D_LIN + 4 * D_ATT
SPLITS = [D_LIN, 2 * D_LIN, 3 * D_LIN, 4 * D_LIN,
          4 * D_LIN + D_ATT, 4 * D_LIN + 2 * D_ATT, 4 * D_LIN + 3 * D_ATT]

kernel_name = "hymba_hgrn2_moba_decode_step"


def rmsnorm(x, g):
    xf = x.astype(jnp.float32)
    xf = xf * lax.rsqrt(jnp.mean(xf * xf, axis=-1, keepdims=True) + EPS)
    return (xf * g.astype(jnp.float32)).astype(x.dtype)


def hgrn2_scan(q, log_f, k, v, s0):
    B, T, H, DK = q.shape
    DV = v.shape[-1]
    C = math.gcd(T, HGRN_CHUNK)
    N = T // C

    def to_chunks(a):
        return a.reshape(B, N, C, H, a.shape[-1]).transpose(1, 0, 3, 2, 4)

    causal = jnp.tril(jnp.ones((C, C), dtype=bool))[:, :, None]

    def step(S, inp):
        qi, gi, ki, vi = inp
        b = jnp.cumsum(gi, axis=2)
        inter = jnp.einsum('bhtk,bhkv->bhtv', qi * jnp.exp(b), S)
        rel = b[:, :, :, None, :] - b[:, :, None, :, :]
        decay = jnp.exp(jnp.where(causal, rel, -jnp.inf))
        att = jnp.einsum('bhtk,bhsk,bhtsk->bhts', qi, ki, decay)
        intra = jnp.einsum('bhts,bhsv->bhtv', att, vi)
        b_last = b[:, :, -1:, :]
        S_new = jnp.exp(b_last[:, :, 0, :])[..., None] * S + jnp.einsum(
            'bhsk,bhsv->bhkv', ki * jnp.exp(b_last - b), vi)
        return S_new, inter + intra

    S_final, o = lax.scan(step, s0, (to_chunks(q), to_chunks(log_f), to_chunks(k), to_chunks(v)))
    o = o.transpose(1, 0, 3, 2, 4).reshape(B, T, H, DV)
    return o, S_final


def t5_bucket(dist):
    max_exact = N_BUCKETS // 2
    n = jnp.maximum(dist, 0)
    large = max_exact + (jnp.log(jnp.maximum(n, 1).astype(jnp.float32) / max_exact)
                         / math.log(MAX_DISTANCE / max_exact) * (N_BUCKETS - max_exact)).astype(jnp.int32)
    large = jnp.minimum(large, N_BUCKETS - 1)
    return jnp.where(n < max_exact, n, large)


def moba_attention(q, k, v, q_pos, rel_bias):
    B, T, H, hd = q.shape
    L = k.shape[1]
    nb = -(-L // MOBA_BLOCK)
    pad = nb * MOBA_BLOCK - L
    k = jnp.pad(k, ((0, 0), (0, pad), (0, 0), (0, 0)))
    v = jnp.pad(v, ((0, 0), (0, pad), (0, 0), (0, 0)))
    kbt = k.reshape(B, nb, MOBA_BLOCK, H, hd).transpose(0, 3, 1, 2, 4)
    vbt = v.reshape(B, nb, MOBA_BLOCK, H, hd).transpose(0, 3, 1, 2, 4)
    k_mean = jnp.mean(kbt.astype(jnp.float32), axis=3)
    n_sel = min(MOBA_TOPK, nb)
    qb = math.gcd(T, max(1, MOBA_Q_ROWS // B))
    n_qb = T // qb
    q_blocks = q.reshape(B, n_qb, qb, H, hd).transpose(1, 0, 3, 2, 4)
    pos_blocks = q_pos.reshape(n_qb, qb)
    bi = jnp.arange(B)[:, None, None, None]
    hi = jnp.arange(H)[None, :, None, None]
    blk_ids = jnp.arange(nb)
    offs = jnp.arange(MOBA_BLOCK)
    scale = hd ** -0.5

    def attend_block(args):
        qi, pos = args
        own = pos // MOBA_BLOCK
        gate = jnp.einsum('bhqd,bhnd->bhqn', qi.astype(jnp.float32), k_mean)
        fully_past = blk_ids[None, :] < own[:, None]
        gate = jnp.where(fully_past, gate, -jnp.inf)
        top_s, top_i = lax.top_k(gate, n_sel)
        sel = jnp.concatenate([top_i, jnp.broadcast_to(own[:, None], (B, H, qb, 1))], axis=-1)
        valid = jnp.concatenate([jnp.isfinite(top_s), jnp.ones((B, H, qb, 1), dtype=bool)], axis=-1)
        kg = kbt[bi, hi, sel]
        vg = vbt[bi, hi, sel]
        dist = pos[:, None, None] - (sel[..., None] * MOBA_BLOCK + offs)
        logits = (jnp.einsum('bhqd,bhqjpd->bhqjp', qi, kg).astype(jnp.float32) * scale
                  + rel_bias[t5_bucket(dist), hi[..., None]].astype(jnp.float32))
        logits = jnp.where(valid[..., None] & (dist >= 0), logits, -jnp.inf)
        p = jax.nn.softmax(logits.reshape(B, H, qb, -1), axis=-1).reshape(logits.shape)
        return jnp.einsum('bhqjp,bhqjpd->bqhd', p.astype(vg.dtype), vg)

    out = lax.map(attend_block, (q_blocks, pos_blocks))
    return out.transpose(1, 0, 2, 3, 4).reshape(B, T, H, hd)


def hybrid_layer(x, k_past, v_past, s0, q_pos, w_in, w_out, g_pre, g_post, g_lin, lb, rel_bias):
    B, T, _ = x.shape
    h = rmsnorm(x, g_pre)
    z = jnp.einsum('btd,de->bte', h, w_in)
    lq, lf, li, lg, aq, ak, av, ag = jnp.split(z, SPLITS, axis=-1)
    f = lb + (1.0 - lb) * jax.nn.sigmoid(lf.astype(jnp.float32))
    shp = (B, T, LIN_HEADS, LIN_HEAD_DIM)
    o_lin, s_new = hgrn2_scan(jax.nn.silu(lq.astype(jnp.float32)).reshape(shp),
                              jnp.log(f).reshape(shp), (1.0 - f).reshape(shp),
                              li.astype(jnp.float32).reshape(shp), s0.astype(jnp.float32))
    o_lin = rmsnorm(o_lin, g_lin).reshape(B, T, D_LIN).astype(x.dtype) * jax.nn.silu(lg)
    ashp = (B, T, ATT_HEADS, ATT_HEAD_DIM)
    qa, ka, va = aq.reshape(ashp), ak.reshape(ashp), av.reshape(ashp)
    k_all = ka if k_past is None else jnp.concatenate([k_past.astype(ka.dtype), ka], axis=1)
    v_all = va if v_past is None else jnp.concatenate([v_past.astype(va.dtype), va], axis=1)
    o_att = moba_attention(qa, k_all, v_all, q_pos, rel_bias).reshape(B, T, D_ATT) * jax.nn.silu(ag)
    o = jnp.einsum('bte,ed->btd', jnp.concatenate([o_lin, o_att], axis=-1), w_out)
    y = x + rmsnorm(o, g_post)
    return y, ka, va, s_new.astype(s0.dtype)


def setup_inputs(seed: int = 0) -> dict:
    key = jax.random.key(seed)
    ks = jax.random.split(key, 14)
    n_pages = PAST_LEN // PAGE_SIZE
    n_phys = (DEC_BATCH * n_pages * 5) // 4
    f32 = jnp.float32
    perm = jax.random.permutation(ks[0], n_phys)[:DEC_BATCH * n_pages]
    return {
        "x_prompt": jax.random.normal(ks[1], (BATCH, SEQ, D_MODEL), f32),
        "x_sample": jax.random.normal(ks[2], (DEC_BATCH, DEC_SEQ, D_MODEL), f32),
        "cache_k": jax.random.normal(ks[3], (DEPTH, n_phys, PAGE_SIZE, ATT_HEADS, ATT_HEAD_DIM), f32),
        "cache_v": jax.random.normal(ks[4], (DEPTH, n_phys, PAGE_SIZE, ATT_HEADS, ATT_HEAD_DIM), f32),
        "state_hgrn": 0.5 * jax.random.normal(ks[5], (DEPTH, DEC_BATCH, LIN_HEADS, LIN_HEAD_DIM, LIN_HEAD_DIM), f32),
        "page_table": perm.reshape(DEC_BATCH, n_pages).astype(jnp.int32),
        "w_in": jax.random.normal(ks[6], (DEPTH, D_MODEL, D_IN), f32) * D_MODEL ** -0.5,
        "w_out": jax.random.normal(ks[7], (DEPTH, D_MIX, D_MODEL), f32) * D_MIX ** -0.5,
        "norm_pre": 1.0 + 0.05 * jax.random.normal(ks[8], (DEPTH, D_MODEL), f32),
        "norm_post": 1.0 + 0.05 * jax.random.normal(ks[9], (DEPTH, D_MODEL), f32),
        "norm_lin_out": 1.0 + 0.05 * jax.random.normal(ks[10], (DEPTH, LIN_HEAD_DIM), f32),
        "lin_lower_bound": jax.random.normal(ks[11], (DEPTH + 1, D_LIN), f32),
        "rel_bias": 0.5 * jax.random.normal(ks[12], (N_BUCKETS, ATT_HEADS), f32),
    }


def reference(x_prompt, x_sample, cache_k, cache_v, state_hgrn, page_table, w_in, w_out,
              norm_pre, norm_post, norm_lin_out, lin_lower_bound, rel_bias):
    n_pages = page_table.shape[1]
    past_len = n_pages * PAGE_SIZE
    pos_prompt = jnp.arange(x_prompt.shape[1], dtype=jnp.int32)
    pos_sample = past_len + jnp.arange(x_sample.shape[1], dtype=jnp.int32)
    lb_all = jnp.cumsum(jax.nn.softmax(lin_lower_bound.astype(jnp.float32), axis=0), axis=0)
    yp, ys = x_prompt, x_sample
    kp_l, vp_l, sp_l, ks_l, vs_l, ss_l = [], [], [], [], [], []
    for l in range(DEPTH):
        lb = lb_all[l]
        Bp = yp.shape[0]
        s0_p = jnp.zeros((Bp, LIN_HEADS, LIN_HEAD_DIM, LIN_HEAD_DIM), state_hgrn.dtype)
        yp, kp, vp, sp = hybrid_layer(yp, None, None, s0_p, pos_prompt, w_in[l], w_out[l],
                                      norm_pre[l], norm_post[l], norm_lin_out[l], lb, rel_bias)
        Bs = ys.shape[0]
        k_past = cache_k[l][page_table].reshape(Bs, past_len, ATT_HEADS, ATT_HEAD_DIM)
        v_past = cache_v[l][page_table].reshape(Bs, past_len, ATT_HEADS, ATT_HEAD_DIM)
        ys, ksn, vsn, ssn = hybrid_layer(ys, k_past, v_past, state_hgrn[l], pos_sample, w_in[l], w_out[l],
                                         norm_pre[l], norm_post[l], norm_lin_out[l], lb, rel_bias)
        kp_l.append(kp); vp_l.append(vp); sp_l.append(sp)
        ks_l.append(ksn); vs_l.append(vsn); ss_l.append(ssn)
    k_prompt_new = jnp.stack(kp_l)
    v_prompt_new = jnp.stack(vp_l)
    state_prompt_new = jnp.stack(sp_l)
    k_sample_new = jnp.stack(ks_l)
    v_sample_new = jnp.stack(vs_l)
    state_sample_new = jnp.stack(ss_l)
    return (yp, ys, k_prompt_new, v_prompt_new, state_prompt_new, k_sample_new, v_sample_new, state_sample_new)
```

```cpp
#define MK_PER_PHASE 0
#include <hip/hip_runtime.h>
#include <cstdio>
#include <cstdint>
#include <cmath>
namespace pg8 {
#define PG8_LAS __attribute__((address_space(3)))
typedef unsigned short bf16_t;
typedef short bf16x8 __attribute__((ext_vector_type(8)));
typedef float f32x4 __attribute__((ext_vector_type(4)));
typedef unsigned u32x4 __attribute__((ext_vector_type(4)));
constexpr int BM = 256, BK = 64, HALF = 128, HTB = HALF * BK * 2  , STAGE_BYTES = 8 * HTB, NXCD = 8, WGM = 8;

__host__ __device__ __forceinline__ int lds_byte(int r, int c) { const int st = (r >> 4) * 2 + (c >> 5), rr = r & 15, cc = c & 31, ob = rr * 64 + cc * 2; return st * 1024 + (ob ^ (((ob >> 9) & 1) << 5)); }
__host__ __device__ __forceinline__ void stage_rc(int b, int& R, int& C) { const int st = b / 1024, sb = b % 1024, swz = sb ^ (((sb >> 9) & 1) << 5); R = (st >> 1) * 16 + swz / 64; C = (st & 1) * 32 + (swz % 64) / 2; }
__host__ __device__ __forceinline__ int perm32(int rho) { const int n = rho >> 4, i = rho & 15; return 8 * (i >> 2) + 4 * n + (i & 3); }

struct Unit { int pm, pn; };
struct Gemm { const bf16_t* A; const bf16_t* Bt; int M, N, K; };

struct StaticOrder {
    int nM, nN, nwg, G, c;
    __host__ __device__ void init(int M, int N, int G_, int c_) { nM = M / BM; nN = N / BM; nwg = nM * nN; G = G_; c = c_; }
    __host__ __device__ bool next(int i, Unit& u) const {
        const long L = (long)i * G + c; if (L >= nwg) return false;
        int wgid = (int)L; { const int q = nwg / NXCD, r = nwg % NXCD, xcd = wgid % NXCD, off = wgid / NXCD; wgid = (xcd < r ? xcd * (q + 1) : r * (q + 1) + (xcd - r) * q) + off; }
        const int nig = WGM * nN, gid = wgid / nig, fm = gid * WGM, gsz = (nM - fm) < WGM ? (nM - fm) : WGM;
        u.pm = fm + ((wgid % nig) % gsz); u.pn = (wgid % nig) / gsz; return true;
    }
    __device__ __forceinline__ void a_ready(const Unit&) const {}
    __device__ __forceinline__ void done(const Unit&) const {}
};

__device__ __forceinline__ unsigned cvt_pk_bf16(float lo, float hi) { unsigned r; asm volatile("v_cvt_pk_bf16_f32 %0, %1, %2" : "=v"(r) : "v"(lo), "v"(hi)); return r; }
typedef float f32x2 __attribute__((ext_vector_type(2)));
template <class Epi, class Sched, bool ALIGN_EPI = false, bool SP2 = false>
__device__ __forceinline__ void gemm_phase(PG8_LAS unsigned char* lds, const Gemm g, const Sched& S, const Epi& E) {
    const int tid = threadIdx.x, wid = __builtin_amdgcn_readfirstlane(tid >> 6), lane = tid & 63, wr = wid >> 2, wc = wid & 3, fr = lane & 15, fq = lane >> 4;
    const int K = g.K, nt = K / BK;
    unsigned voffA[2], voffB[2];
#pragma unroll
    for (int i = 0; i < 2; ++i) { int R, C; stage_rc(tid * 16 + i * 8192, R, C); const int Rb = Epi::PERM ? ((R & ~31) + perm32(R & 31)) : R;
        voffA[i] = (unsigned)(R * K + C) * 2u; voffB[i] = (unsigned)(Rb * K + C) * 2u; }
    const size_t kstep = (size_t)(BK * 2);
    const size_t hstep = (size_t)HALF * K * 2;
    const size_t tstep = 2 * hstep;
    const unsigned ldsw = (unsigned)wid * 1024u;
    const int aoff = lds_byte(wr * 64 + fr, fq * 8), boff = lds_byte(wc * 32 + fr, fq * 8);
#define PG8_SA(b, h) (((b) * 2 + (h)) * HTB)
#define PG8_SB(b, h) ((4 + (b) * 2 + (h)) * HTB)
#define PG8_STAGE(bufoff, gbase, voff) do { _Pragma("unroll") for (int _i = 0; _i < 2; ++_i) \
        __builtin_amdgcn_global_load_lds((const unsigned*)((const char*)(gbase) + (voff)[_i]), (PG8_LAS unsigned*)(lds + (bufoff) + ldsw + _i * 8192), 16, 0, 0); } while (0)
#define PG8_LDA(dst, b, h) do { _Pragma("unroll") for (int m = 0; m < 4; ++m) _Pragma("unroll") for (int k = 0; k < 2; ++k) dst[m][k] = *(const PG8_LAS bf16x8*)(lds + PG8_SA(b, h) + aoff + m * 2048 + k * 1024); } while (0)
#define PG8_LDB(dst, b, h) do { _Pragma("unroll") for (int n = 0; n < 2; ++n) _Pragma("unroll") for (int k = 0; k < 2; ++k) dst[n][k] = *(const PG8_LAS bf16x8*)(lds + PG8_SB(b, h) + boff + n * 2048 + k * 1024); } while (0)
#define PG8_MMA(ai, bj, At, Bt) do { __builtin_amdgcn_s_setprio(1); _Pragma("unroll") for (int m = 0; m < 4; ++m) _Pragma("unroll") for (int n = 0; n < 2; ++n) _Pragma("unroll") for (int k = 0; k < 2; ++k) \
        acc[ai][bj][m][n] = __builtin_amdgcn_mfma_f32_16x16x32_bf16(Bt[n][k], At[m][k], acc[ai][bj][m][n], 0, 0, 0); __builtin_amdgcn_s_setprio(0); } while (0)
#define PG8_WAIT_V(n) asm volatile("s_waitcnt vmcnt(" #n ")" ::: "memory")
#define PG8_WAIT_L(n) asm volatile("s_waitcnt lgkmcnt(" #n ")" ::: "memory")
#define PG8_BAR __builtin_amdgcn_s_barrier()
#define PG8_SCHED __builtin_amdgcn_sched_barrier(0)
    Unit cur, nxt; int ui = 0;
    if (!S.next(0, cur)) return;
    f32x4 acc[2][2][4][2];
#pragma unroll
    for (int a = 0; a < 2; ++a)
#pragma unroll
        for (int b = 0; b < 2; ++b)
#pragma unroll
            for (int m = 0; m < 4; ++m)
#pragma unroll
                for (int n = 0; n < 2; ++n) acc[a][b][m][n] = (f32x4){0.f, 0.f, 0.f, 0.f};
    bf16x8 At[4][2], B0[2][2], B1[2][2];
    const char* cA = (const char*)g.A + (size_t)cur.pm * tstep; const char* cB = (const char*)g.Bt + (size_t)cur.pn * tstep;
    S.a_ready(cur);
    if constexpr (SP2) {
        PG8_STAGE(PG8_SB(0, 0), cB, voffB); PG8_STAGE(PG8_SB(0, 1), cB + hstep, voffB); PG8_STAGE(PG8_SA(0, 0), cA, voffA); PG8_STAGE(PG8_SA(0, 1), cA + hstep, voffA);
        if (wr == 1) PG8_BAR;
        PG8_WAIT_V(2); PG8_BAR;
        PG8_STAGE(PG8_SB(1, 0), cB + kstep, voffB); PG8_STAGE(PG8_SA(1, 0), cA + kstep, voffA); PG8_STAGE(PG8_SB(1, 1), cB + hstep + kstep, voffB);
        PG8_WAIT_V(6); PG8_BAR;
    } else {
        PG8_STAGE(PG8_SB(0, 0), cB, voffB); PG8_STAGE(PG8_SA(0, 0), cA, voffA); PG8_STAGE(PG8_SB(0, 1), cB + hstep, voffB); PG8_STAGE(PG8_SA(0, 1), cA + hstep, voffA);
        if (wr == 1) PG8_BAR;
        PG8_WAIT_V(4); PG8_BAR;
        PG8_STAGE(PG8_SB(1, 0), cB + kstep, voffB); PG8_STAGE(PG8_SA(1, 0), cA + kstep, voffA); PG8_STAGE(PG8_SB(1, 1), cB + hstep + kstep, voffB);
        PG8_WAIT_V(6); PG8_BAR;
    }
    for (;;) {
        const bool has_next = S.next(ui + 1, nxt);
        const char* nA = has_next ? (const char*)g.A + (size_t)nxt.pm * tstep : cA; const char* nB = has_next ? (const char*)g.Bt + (size_t)nxt.pn * tstep : cB;
        for (int t = 0; t < nt; t += 2) {
            const bool last = (t == nt - 2);
            const char* a1 = cA + (size_t)(t + 1) * kstep;
            const char* a2 = last ? nA : cA + (size_t)(t + 2) * kstep; const char* b2 = last ? nB : cB + (size_t)(t + 2) * kstep;
            const char* a3 = a2 + kstep; const char* b3 = b2 + kstep;
            if (last && has_next) S.a_ready(nxt);
            if constexpr (SP2) {
            PG8_LDB(B0, 0, 0); PG8_LDB(B1, 0, 1); PG8_SCHED; PG8_LDA(At, 0, 0); PG8_STAGE(PG8_SA(1, 1), a1 + hstep, voffA);
            PG8_WAIT_V(8); PG8_WAIT_L(0); PG8_BAR; PG8_MMA(0, 0, At, B0); PG8_MMA(0, 1, At, B1); PG8_BAR; PG8_SCHED;
            PG8_LDA(At, 0, 1); PG8_STAGE(PG8_SB(0, 0), b2, voffB); PG8_STAGE(PG8_SB(0, 1), b2 + hstep, voffB); PG8_STAGE(PG8_SA(0, 0), a2, voffA);
            PG8_WAIT_V(8); PG8_WAIT_L(0); PG8_BAR; PG8_MMA(1, 0, At, B0); PG8_MMA(1, 1, At, B1); PG8_BAR; PG8_SCHED;
            PG8_LDB(B0, 1, 0); PG8_LDB(B1, 1, 1); PG8_SCHED; PG8_LDA(At, 1, 0); PG8_STAGE(PG8_SA(0, 1), a2 + hstep, voffA);
            PG8_WAIT_V(8); PG8_WAIT_L(0); PG8_BAR; PG8_MMA(0, 0, At, B0); PG8_MMA(0, 1, At, B1); PG8_BAR; PG8_SCHED;
            PG8_LDA(At, 1, 1); PG8_STAGE(PG8_SB(1, 0), b3, voffB); PG8_STAGE(PG8_SB(1, 1), b3 + hstep, voffB); PG8_STAGE(PG8_SA(1, 0), a3, voffA);
            PG8_WAIT_V(8); PG8_WAIT_L(0); PG8_BAR; PG8_MMA(1, 0, At, B0); PG8_MMA(1, 1, At, B1); PG8_BAR; PG8_SCHED;
            } else {
            PG8_LDB(B0, 0, 0); PG8_SCHED; PG8_LDA(At, 0, 0); PG8_STAGE(PG8_SA(1, 1), a1 + hstep, voffA);
            PG8_WAIT_L(8); PG8_BAR; PG8_WAIT_L(0); PG8_MMA(0, 0, At, B0); PG8_BAR; PG8_SCHED;
            PG8_LDB(B1, 0, 1); PG8_STAGE(PG8_SB(0, 0), b2, voffB);
            PG8_BAR; PG8_WAIT_L(0); PG8_MMA(0, 1, At, B1); PG8_BAR;
            PG8_LDA(At, 0, 1); PG8_STAGE(PG8_SA(0, 0), a2, voffA);
            PG8_BAR; PG8_WAIT_L(0); PG8_MMA(1, 0, At, B0); PG8_BAR; PG8_SCHED;
            PG8_STAGE(PG8_SB(0, 1), b2 + hstep, voffB);
            PG8_WAIT_V(6); PG8_BAR; PG8_MMA(1, 1, At, B1); PG8_BAR;
            PG8_LDB(B0, 1, 0); PG8_SCHED; PG8_LDA(At, 1, 0); PG8_STAGE(PG8_SA(0, 1), a2 + hstep, voffA);
            PG8_WAIT_L(8); PG8_BAR; PG8_WAIT_L(0); PG8_MMA(0, 0, At, B0); PG8_BAR; PG8_SCHED;
            PG8_LDB(B1, 1, 1); PG8_STAGE(PG8_SB(1, 0), b3, voffB);
            PG8_BAR; PG8_WAIT_L(0); PG8_MMA(0, 1, At, B1); PG8_BAR;
            PG8_LDA(At, 1, 1); PG8_STAGE(PG8_SA(1, 0), a3, voffA);
            PG8_BAR; PG8_WAIT_L(0); PG8_MMA(1, 0, At, B0); PG8_BAR; PG8_SCHED;
            PG8_STAGE(PG8_SB(1, 1), b3 + hstep, voffB);
            PG8_WAIT_V(6); PG8_BAR; PG8_MMA(1, 1, At, B1); PG8_BAR;
            }
        }
        if constexpr (ALIGN_EPI) { if (wr == 0) PG8_BAR; }
        if constexpr (!Epi::AFTER_DRAIN) { E(acc, cur, wr, wc, fr, fq); S.done(cur); }
        if (!has_next) break;
#pragma unroll
        for (int a = 0; a < 2; ++a)
#pragma unroll
            for (int b = 0; b < 2; ++b)
#pragma unroll
                for (int m = 0; m < 4; ++m)
#pragma unroll
                    for (int n = 0; n < 2; ++n) acc[a][b][m][n] = (f32x4){0.f, 0.f, 0.f, 0.f};
        cur = nxt; cA = nA; cB = nB; ++ui;
        if constexpr (ALIGN_EPI) { if (wr == 1) PG8_BAR; }
    }
    PG8_WAIT_V(0);
    if constexpr (!ALIGN_EPI) { if (wr == 0) PG8_BAR; }
    PG8_BAR;
    if constexpr (Epi::AFTER_DRAIN) { E.fused(acc, cur, wr, wc, fr, fq, lds, wid, lane); S.done(cur); }
#undef PG8_SA
#undef PG8_SB
#undef PG8_STAGE
#undef PG8_LDA
#undef PG8_LDB
#undef PG8_MMA
#undef PG8_WAIT_V
#undef PG8_WAIT_L
#undef PG8_BAR
#undef PG8_SCHED
}
}

constexpr int NWAVES = 8, NTHR = 512;
constexpr int DM = 1024, SEQ = 4096, NBATCH = 4, MP = NBATCH * SEQ, DECB = 128, DECS = 4, MS = DECB * DECS, MROWS = MP + MS;
constexpr int DIN = 4096, DL = 512;
constexpr float EPSN = 1e-6f;
constexpr float LOG2E = 1.4426950408889634f;
constexpr float QSCALE = 0.125f * LOG2E;
constexpr float NEGBIG = -1.0e30f;
constexpr int PASTLEN = 2048;
constexpr size_t O_YP = 0, O_YS = O_YP + (size_t)MP * DM, O_KP = O_YS + (size_t)MS * DM, O_VP = O_KP + (size_t)MP * 512, O_SP = O_VP + (size_t)MP * 512,
                 O_KS = O_SP + (size_t)16 * 16384, O_VS = O_KS + (size_t)MS * 512, O_SS = O_VS + (size_t)MS * 512, O_END = O_SS + (size_t)512 * 16384;
constexpr size_t MiB = 1u << 20;
constexpr size_t WS_CTL = 0, CTL_ZERO_BYTES = 1 * MiB;
constexpr size_t WS_WIN = 2 * MiB, WS_WOUT = 10 * MiB, WS_TAB = 12 * MiB, WS_LB = 12 * MiB + 256 * 1024, WS_KMP = 13 * MiB, WS_GATE = 13 * MiB + 512 * 1024,
                 WS_ML = 14 * MiB, WS_DC = 15 * MiB, WS_H = 16 * MiB, WS_QL = 50 * MiB, WS_VL = 67 * MiB, WS_GTL = 84 * MiB, WS_QA = 101 * MiB, WS_KA = 118 * MiB,
                 WS_VA = 135 * MiB, WS_GTA = 152 * MiB, WS_GL = 170 * MiB, WS_L = 204 * MiB, WS_SC = 268 * MiB, WS_LOG = 300 * MiB, WS_OPART = 332 * MiB,
                 WS_OMIX = 340 * MiB, WS_O2 = 374 * MiB, WS_END = 440 * MiB;
constexpr int CW_BAR = 4096;
constexpr int RING_OFF = 0, RING_BYTES = 131072;
constexpr int LDSCTL_OFF = RING_BYTES, MISC_OFF = LDSCTL_OFF + 320;
constexpr int LDS_BYTES = 147456;

#define GAS __attribute__((address_space(1)))
#define LAS __attribute__((address_space(3)))
typedef unsigned short bf16;
typedef unsigned v4u __attribute__((ext_vector_type(4)));
typedef float f32x4 __attribute__((ext_vector_type(4)));
typedef short bf16x8 __attribute__((ext_vector_type(8)));
typedef GAS unsigned gu32;
typedef GAS unsigned long long gu64;
#define RLX_AGENT __ATOMIC_RELAXED, __HIP_MEMORY_SCOPE_AGENT
#define LDS_WAIT() asm volatile("s_waitcnt lgkmcnt(0)" ::: "memory")
#define VM_WAIT() asm volatile("s_waitcnt vmcnt(0)" ::: "memory")
__device__ __forceinline__ unsigned long long rt() { return __builtin_amdgcn_s_memrealtime(); }
__device__ __forceinline__ unsigned f2bf(float f) { unsigned u = __builtin_bit_cast(unsigned, f); return (u + 0x7fffu + ((u >> 16) & 1u)) >> 16; }
__device__ __forceinline__ unsigned pk2(float lo, float hi) { return f2bf(lo) | (f2bf(hi) << 16); }

#define XB_TMO      128
#define XB_XCNT(j)  (256  + 64 * (j))
#define XB_XSUB(j)  (1280 + 64 * (j))
#define XB_XGEN(j)  (2304 + 64 * (j))
#define XB_TOP      3328
#define XB_TOPGEN   3392
#define XCD_BAR_WORDS 3456
#define XB_SPIN_CAP (1u << 18)

__device__ __forceinline__ unsigned xb_ld(unsigned* p)              { return __hip_atomic_load(p, __ATOMIC_RELAXED, __HIP_MEMORY_SCOPE_AGENT); }
__device__ __forceinline__ unsigned xb_add(unsigned* p, unsigned v) { return __hip_atomic_fetch_add(p, v, __ATOMIC_RELAXED, __HIP_MEMORY_SCOPE_AGENT); }
__device__ __forceinline__ unsigned xb_xcc_id() { return (unsigned)__builtin_amdgcn_s_getreg((3 << 11) | 20) & 0xFu; }
#define XB_SPIN(cond, bar) do { unsigned _sp = 0; while (cond) { __builtin_amdgcn_s_sleep(1); \
    if ((++_sp & 255u) == 0u) { if (xb_ld(&(bar)[XB_TMO])) break; if (_sp > XB_SPIN_CAP) { atomicAdd(&(bar)[XB_TMO], 1u); break; } } } } while (0)

struct XcdBarrier {
    unsigned* bar; unsigned x;
    volatile LAS unsigned* st;
};

__device__ __forceinline__ XcdBarrier xcd_barrier_post(unsigned* bar, volatile LAS unsigned* st) {
    XcdBarrier b; b.bar = bar; b.x = xb_xcc_id(); b.st = st;
    if (threadIdx.x == 0) (void)xb_add(&bar[XB_XCNT(b.x)], 1u);
    return b;
}
__device__ __forceinline__ void xcd_barrier_complete(unsigned* bar, unsigned x, unsigned& nloc, unsigned& nx) {
    const unsigned G = gridDim.x * gridDim.y * gridDim.z;
    unsigned sum, cnt, mine, sp = 0u;
    for (;;) {
        sum = 0u; cnt = 0u; mine = 0u;
#pragma unroll
        for (unsigned j = 0; j < 16; ++j) { const unsigned c = xb_ld(&bar[XB_XCNT(j)]); sum += c; cnt += (c > 0u) ? 1u : 0u; mine = (j == x) ? c : mine; }
        if (sum == G) break;
        __builtin_amdgcn_s_sleep(1);
        if ((++sp & 255u) == 0u) { if (xb_ld(&bar[XB_TMO])) break; if (sp > XB_SPIN_CAP) { atomicAdd(&bar[XB_TMO], 1u); break; } }
    }
    nloc = mine > 0u ? mine : 1u; nx = cnt > 0u ? cnt : 1u;
}

__device__ __forceinline__ void xcd_barrier(const XcdBarrier& b) {
    asm volatile("s_waitcnt vmcnt(0)" ::: "memory");
    __syncthreads();
    if (threadIdx.x == 0) {
        unsigned* bar = b.bar;
        __builtin_amdgcn_s_waitcnt(0);
        unsigned nloc = b.st[0], nx = b.st[1];
        if (nloc == 0u) { xcd_barrier_complete(bar, b.x, nloc, nx); b.st[0] = nloc; b.st[1] = nx; }
        const unsigned old = xb_add(&bar[XB_XSUB(b.x)], 1u);
        const unsigned gen = old / nloc;
        if (old + 1u == (gen + 1u) * nloc) {
            __builtin_amdgcn_fence(__ATOMIC_RELEASE, "agent");
            asm volatile("s_waitcnt vmcnt(0)" ::: "memory");
            const unsigned og = xb_add(&bar[XB_TOP], 1u);
            const unsigned tg = og / nx;
            if (og + 1u == (tg + 1u) * nx) xb_add(&bar[XB_TOPGEN], 1u);
            else XB_SPIN(xb_ld(&bar[XB_TOPGEN]) == tg, bar);
            __builtin_amdgcn_fence(__ATOMIC_ACQUIRE, "agent");
            xb_add(&bar[XB_XGEN(b.x)], 1u);
            asm volatile("s_waitcnt vmcnt(0)" ::: "memory");
        } else {
            XB_SPIN(xb_ld(&bar[XB_XGEN(b.x)]) == gen, bar);
            __builtin_amdgcn_fence(__ATOMIC_ACQUIRE, "agent");
            asm volatile("s_waitcnt vmcnt(0)" ::: "memory");
        }
    }
    __syncthreads();
}
__device__ __forceinline__ void p0_transpose_item(const float* W, int K, int N, bf16* WT, int row_off, LAS float* scr, int item, int lane) {
    const int nblk = N / 32, kb = item / nblk, nb = item % nblk, k0 = 64 * kb, n0 = 32 * nb;
#pragma unroll 8
    for (int i = 0; i < 32; ++i) { const int kk = 2 * i + (lane >> 5); scr[kk * 33 + (lane & 31)] = W[(size_t)(k0 + kk) * N + n0 + (lane & 31)]; }
    LDS_WAIT(); asm volatile("" ::: "memory");
    const int c = lane & 7;
#pragma unroll
    for (int j = 0; j < 4; ++j) { const int n = (lane >> 3) + 8 * j; const LAS float* s = scr + (8 * c) * 33 + n;
        v4u o; o.x = pk2(s[0 * 33], s[1 * 33]); o.y = pk2(s[2 * 33], s[3 * 33]); o.z = pk2(s[4 * 33], s[5 * 33]); o.w = pk2(s[6 * 33], s[7 * 33]);
        *(GAS v4u*)(WT + (size_t)(row_off + n0 + n) * K + k0 + 8 * c) = o; }
    LDS_WAIT(); asm volatile("" ::: "memory");
}

typedef short v4i16_t __attribute__((ext_vector_type(4)));
typedef float f32x16 __attribute__((ext_vector_type(16)));
typedef float f32x2 __attribute__((ext_vector_type(2)));
struct Frame {
    LAS unsigned char* lds;
    volatile LAS unsigned* MISC;
    gu32* ctl;
    int tid, lane, wave, G, bid;
    const float *xp, *xs, *cache_k, *cache_v, *state, *w_in, *w_out, *norm_pre, *norm_post, *norm_lin, *llb, *rel_bias;
    const int* page_table;
    float* out;
    bf16 *WIN, *WOUT, *H, *QL, *VL, *GTL, *QA, *KA, *VA, *GTA, *SC, *OMIX;
    float *TAB, *LB, *KMP, *GATE, *ML, *DC, *GL, *L, *LOG, *OPART, *O2;
};
__device__ __forceinline__ float bf2f(bf16 b) { return __uint_as_float((unsigned)b << 16); }
__device__ __forceinline__ float bflo(unsigned w) { return __uint_as_float(w << 16); }
__device__ __forceinline__ float bfhi(unsigned w) { return __uint_as_float(w & 0xffff0000u); }
__device__ __forceinline__ float ex2(float x) { return __builtin_amdgcn_exp2f(x); }
__device__ __forceinline__ float wave_sum(float v) {
#pragma unroll
    for (int o = 1; o < 64; o <<= 1) v += __shfl_xor(v, o);
    return v;
}
__device__ __forceinline__ float wave_max(float v) {
#pragma unroll
    for (int o = 1; o < 64; o <<= 1) v = fmaxf(v, __shfl_xor(v, o));
    return v;
}
__device__ __forceinline__ int crow(int r, int hi) { return (r & 3) + 8 * (r >> 2) + 4 * hi; }
__device__ __forceinline__ bf16x8 trpair(const LAS bf16* p0, const LAS bf16* p1) {
    const v4i16_t a = __builtin_amdgcn_ds_read_tr16_b64_v4i16((LAS v4i16_t*)p0);
    const v4i16_t b = __builtin_amdgcn_ds_read_tr16_b64_v4i16((LAS v4i16_t*)p1);
    return (bf16x8){a[0], a[1], a[2], a[3], b[0], b[1], b[2], b[3]};
}
__device__ __forceinline__ bf16x8 pack8(float a0, float a1, float a2, float a3, float a4, float a5, float a6, float a7) {
    v4u w; w.x = pg8::cvt_pk_bf16(a0, a1); w.y = pg8::cvt_pk_bf16(a2, a3); w.z = pg8::cvt_pk_bf16(a4, a5); w.w = pg8::cvt_pk_bf16(a6, a7);
    return __builtin_bit_cast(bf16x8, w);
}
__device__ __forceinline__ unsigned top3mask8(const float (&g)[8]) {
    unsigned mask = 0;
#pragma unroll
    for (int n = 0; n < 3; ++n) { float bv = -INFINITY; int bi = 0;
#pragma unroll
        for (int j = 0; j < 8; ++j) { const bool free = !((mask >> j) & 1u); if (free && g[j] > bv) { bv = g[j]; bi = j; } }
        mask |= 1u << bi; }
    return mask;
}

__device__ __forceinline__ void rms_row_to_bf16(const float* xrow, const float* g, bf16* orow, int lane) {
    const GAS f32x4* xr = (const GAS f32x4*)xrow + lane; const GAS f32x4* gr = (const GAS f32x4*)g + lane;
    f32x4 v[4]; float s = 0.f;
#pragma unroll
    for (int j = 0; j < 4; ++j) { v[j] = xr[64 * j]; s += (v[j].x * v[j].x + v[j].y * v[j].y) + (v[j].z * v[j].z + v[j].w * v[j].w); }
    const float rstd = 1.0f / sqrtf(wave_sum(s) * (1.f / DM) + EPSN);
    GAS unsigned long long* o8 = (GAS unsigned long long*)orow + lane;
#pragma unroll
    for (int j = 0; j < 4; ++j) { const f32x4 gv = gr[64 * j];
        o8[64 * j] = (unsigned long long)pk2(v[j].x * rstd * gv.x, v[j].y * rstd * gv.y) | ((unsigned long long)pk2(v[j].z * rstd * gv.z, v[j].w * rstd * gv.w) << 32); }
}
__device__ __forceinline__ void p0_prologue(Frame& F) {
    LAS float* scr = (LAS float*)(F.lds + RING_OFF + F.wave * 16384);
    const int gw = F.bid * NWAVES + F.wave, NGW = F.G * NWAVES;
    constexpr int I_IN = (DM / 64) * (DIN / 32), I_OUT = (DM / 64) * (DM / 32);
    for (int it = gw; it < I_IN + I_OUT; it += NGW) {
        if (it < I_IN) p0_transpose_item(F.w_in, DM, DIN, F.WIN, 0, scr, it, F.lane);
        else p0_transpose_item(F.w_out, DM, DM, F.WOUT, 0, scr, it - I_IN, F.lane);
    }
    for (int m = gw; m < MROWS; m += NGW) {
        const float* xrow = m < MP ? F.xp + (size_t)m * DM : F.xs + (size_t)(m - MP) * DM;
        rms_row_to_bf16(xrow, F.norm_pre, F.H + (size_t)m * DM, F.lane);
    }
    const int gt = F.bid * NTHR + F.tid, NGT = F.G * NTHR;
    for (int i = gt; i < DL; i += NGT) F.LB[i] = 1.0f / (1.0f + expf(F.llb[DL + i] - F.llb[i]));
    for (int i = gt; i < 8 * 4096; i += NGT) { const int h = i >> 12, d = i & 4095; int bk;
        if (d < 16) bk = d; else { const float lg = logf((float)d / 16.0f) / 4.1588830833596715f * 16.0f; int q = 16 + (int)lg; bk = q < 31 ? q : 31; }
        F.TAB[i] = F.rel_bias[bk * 8 + h] * LOG2E; }
}

struct Epi1 {
    static constexpr bool PERM = true, AFTER_DRAIN = false;
    unsigned char* ws; float* out; const float* lb;
    __device__ __forceinline__ void operator()(const pg8::f32x4 (&acc)[2][2][4][2], const pg8::Unit& u, int wr, int wc, int fr, int fq) const {
        const int type = u.pn >> 1;
        const int cg0 = (u.pn & 1) * 256 + wc * 32 + 8 * fq;
        const int row0 = u.pm * 256 + wr * 64 + fr;
        size_t bofs = WS_QL;
        switch (type) { case 0: bofs = WS_QL; break; case 2: bofs = WS_VL; break; case 3: bofs = WS_GTL; break; case 4: bofs = WS_QA; break; case 5: bofs = WS_KA; break; case 6: bofs = WS_VA; break; case 7: bofs = WS_GTA; break; default: break; }
        bf16* dstb = (bf16*)(ws + bofs);
        float* dstf = nullptr;
        if (type == 1) dstf = (float*)(ws + WS_GL);
        if (type == 5) dstf = (u.pm < 64) ? out + O_KP : out + O_KS - (size_t)MP * 512;
        if (type == 6) dstf = (u.pm < 64) ? out + O_VP : out + O_VS - (size_t)MP * 512;
        float lbv[2][8];
#pragma unroll
        for (int bj = 0; bj < 2; ++bj)
#pragma unroll
            for (int i = 0; i < 8; ++i) lbv[bj][i] = (type == 1) ? lb[cg0 + bj * 128 + i] : 0.f;
#pragma unroll
        for (int ai = 0; ai < 2; ++ai)
#pragma unroll
            for (int m = 0; m < 4; ++m) { const size_t row = (size_t)(row0 + ai * 128 + m * 16);
#pragma unroll
                for (int bj = 0; bj < 2; ++bj) { const int col = cg0 + bj * 128;
                    float v[8];
#pragma unroll
                    for (int i = 0; i < 4; ++i) { v[i] = acc[ai][bj][m][0][i]; v[4 + i] = acc[ai][bj][m][1][i]; }
                    if (type == 0 || type == 3 || type == 7) {
#pragma unroll
                        for (int i = 0; i < 8; ++i) v[i] = v[i] / (1.0f + __expf(-v[i]));
                    } else if (type == 1) {
#pragma unroll
                        for (int i = 0; i < 8; ++i) { const float s = 1.0f / (1.0f + __expf(-v[i])); v[i] = __logf(lbv[bj][i] + (1.0f - lbv[bj][i]) * s); }
                    } else if (type == 4) {
#pragma unroll
                        for (int i = 0; i < 8; ++i) v[i] *= QSCALE;
                    }
                    if (type == 1 || type == 5 || type == 6) { float* p = dstf + row * 512 + col;
                        *(pg8::f32x4*)p = (pg8::f32x4){v[0], v[1], v[2], v[3]}; *(pg8::f32x4*)(p + 4) = (pg8::f32x4){v[4], v[5], v[6], v[7]}; }
                    if (type != 1) { pg8::u32x4 w; w.x = pg8::cvt_pk_bf16(v[0], v[1]); w.y = pg8::cvt_pk_bf16(v[2], v[3]); w.z = pg8::cvt_pk_bf16(v[4], v[5]); w.w = pg8::cvt_pk_bf16(v[6], v[7]);
                        *(pg8::u32x4*)(dstb + row * 512 + col) = w; }
                } }
    }
};
struct Epi2 {
    static constexpr bool PERM = false, AFTER_DRAIN = false;
    float* O2;
    __device__ __forceinline__ void operator()(const pg8::f32x4 (&acc)[2][2][4][2], const pg8::Unit& u, int wr, int wc, int fr, int fq) const {
        const int row0 = u.pm * 256 + wr * 64 + fr, col0 = u.pn * 256 + wc * 32 + 4 * fq;
#pragma unroll
        for (int ai = 0; ai < 2; ++ai)
#pragma unroll
            for (int m = 0; m < 4; ++m) { float* rp = O2 + (size_t)(row0 + ai * 128 + m * 16) * DM + col0;
#pragma unroll
                for (int bj = 0; bj < 2; ++bj)
#pragma unroll
                    for (int n = 0; n < 2; ++n) *(pg8::f32x4*)(rp + bj * 128 + n * 16) = acc[ai][bj][m][n]; }
    }
};

__device__ __forceinline__ void ha_unit(Frame& F, int unit) {
    const int c = unit & 63, bh = unit >> 6, h = bh & 3, b = bh >> 2;
    const size_t r0 = (size_t)b * SEQ + c * 64;
    LAS float* tot = (LAS float*)F.lds;
    LAS bf16* KhT = (LAS bf16*)(F.lds + 2048);
    LAS bf16* Vs = (LAS bf16*)(F.lds + 2048 + 18432);
    const int tid = F.tid, lane = F.lane, k = tid & 127, tg = tid >> 7, hi = lane >> 5;
    const float* gp = F.GL + (r0 + tg * 16) * 512 + h * 128 + k;
    float gv[16], cs[16]; float run = 0.f;
#pragma unroll
    for (int i = 0; i < 16; ++i) gv[i] = gp[(size_t)i * 512];
    v4u vreg[2];
#pragma unroll
    for (int i = 0; i < 2; ++i) { const int idx = tid + 512 * i, s = idx >> 4, ch = idx & 15; vreg[i] = *(const v4u*)(F.VL + (r0 + s) * 512 + h * 128 + ch * 8); }
#pragma unroll
    for (int i = 0; i < 16; ++i) { run += gv[i]; cs[i] = run; }
    tot[tg * 128 + k] = run;
    __syncthreads();
    const float t0 = tot[k], t1 = tot[128 + k], t2 = tot[256 + k], t3 = tot[384 + k];
    const float prefix = (tg > 0 ? t0 : 0.f) + (tg > 1 ? t1 : 0.f) + (tg > 2 ? t2 : 0.f), total = (t0 + t1) + (t2 + t3);
    unsigned pk[8];
#pragma unroll
    for (int i = 0; i < 16; i += 2) {
        const float a = (1.0f - __expf(gv[i])) * __expf(total - (prefix + cs[i])), bq = (1.0f - __expf(gv[i + 1])) * __expf(total - (prefix + cs[i + 1]));
        pk[i >> 1] = pg8::cvt_pk_bf16(a, bq); }
    *(LAS v4u*)(KhT + k * 72 + tg * 16) = (v4u){pk[0], pk[1], pk[2], pk[3]};
    *(LAS v4u*)(KhT + k * 72 + tg * 16 + 8) = (v4u){pk[4], pk[5], pk[6], pk[7]};
#pragma unroll
    for (int i = 0; i < 2; ++i) { const int idx = tid + 512 * i, s = idx >> 4, ch = idx & 15; *(LAS v4u*)(Vs + s * 144 + ch * 8) = vreg[i]; }
    if (tg == 0) F.DC[unit * 128 + k] = __expf(total);
    __syncthreads();
    const int w = F.wave, kt = w >> 1, g4 = lane >> 4, i16 = lane & 15;
#pragma unroll
    for (int vv = 0; vv < 2; ++vv) { const int vt = (w & 1) * 2 + vv;
        f32x16 acc = {};
#pragma unroll
        for (int ks = 0; ks < 4; ++ks) {
            const bf16x8 A = *(const LAS bf16x8*)(KhT + (32 * kt + (lane & 31)) * 72 + 16 * ks + 8 * hi);
            const int rowb = 16 * ks + 8 * (g4 >> 1) + (i16 >> 2), col = 32 * vt + 16 * (g4 & 1) + 4 * (i16 & 3);
            const bf16x8 B = trpair(Vs + rowb * 144 + col, Vs + (rowb + 4) * 144 + col);
            acc = __builtin_amdgcn_mfma_f32_32x32x16_bf16(A, B, acc, 0, 0, 0); }
        float* Lp = F.L + ((size_t)unit * 128 + 32 * kt) * 128 + 32 * vt + (lane & 31);
#pragma unroll
        for (int r = 0; r < 16; ++r) Lp[(size_t)crow(r, hi) * 128] = acc[r];
    }
    __syncthreads();
}
__device__ __forceinline__ void km_unit(Frame& F, int unit) {
    LAS float* red = (LAS float*)F.lds;
    const int tid = F.tid, c4 = tid & 127, rq = tid >> 7;
    const float* kp = F.out + O_KP + ((size_t)unit * 64 + rq * 16) * 512 + c4 * 4;
    f32x4 s = {0.f, 0.f, 0.f, 0.f};
#pragma unroll
    for (int i = 0; i < 16; ++i) s += *(const f32x4*)(kp + (size_t)i * 512);
    *(LAS f32x4*)(red + rq * 512 + c4 * 4) = s;
    __syncthreads();
    F.KMP[(size_t)unit * 512 + tid] = (red[tid] + red[512 + tid]) + (red[1024 + tid] + red[1536 + tid]);
    __syncthreads();
}
__device__ __forceinline__ void sh_unit(Frame& F, int unit) {
    const int h = unit & 3, b = unit >> 2, tid = F.tid, lane = F.lane;
    LAS float* fv = (LAS float*)F.lds;
    LAS float* kv = fv + 512; LAS float* qv = fv + 1024; LAS float* vv = fv + 1536;
    LAS float* part = fv + 2048;
    LAS float* red = part + 8192;
    { const int t = tid >> 7, k = tid & 127; const size_t row = (size_t)MP + b * 4 + t; const size_t o = row * 512 + h * 128 + k;
      const float f = __expf(F.GL[o]); fv[tid] = f; kv[tid] = 1.0f - f; qv[tid] = bf2f(F.QL[o]); vv[tid] = bf2f(F.VL[o]); }
    const int kq = tid >> 5, v4 = tid & 31;
    const size_t sbase = ((size_t)unit * 128 + 8 * kq) * 128 + 4 * v4;
    f32x4 S[8];
#pragma unroll
    for (int i = 0; i < 8; ++i) S[i] = *(const f32x4*)(F.state + sbase + (size_t)i * 128);
    __syncthreads();
#pragma unroll
    for (int t = 0; t < 4; ++t) { const f32x4 vt = *(const LAS f32x4*)(vv + t * 128 + 4 * v4); f32x4 po = {0.f, 0.f, 0.f, 0.f};
#pragma unroll
        for (int i = 0; i < 8; ++i) { const int k = 8 * kq + i; const float f = fv[t * 128 + k], kk = kv[t * 128 + k], q = qv[t * 128 + k];
            S[i] = S[i] * f + vt * kk; po += S[i] * q; }
        *(LAS f32x4*)(part + (t * 16 + kq) * 128 + 4 * v4) = po; }
#pragma unroll
    for (int i = 0; i < 8; ++i) *(f32x4*)(F.out + O_SS + sbase + (size_t)i * 128) = S[i];
    __syncthreads();
    { const int t = tid >> 7, v = tid & 127; float o = 0.f;
#pragma unroll
      for (int q = 0; q < 16; ++q) o += part[(t * 16 + q) * 128 + v];
      const float ss = wave_sum(o * o);
      if (lane == 0) red[F.wave] = ss;
      __syncthreads();
      const float rstd = 1.0f / sqrtf((red[2 * t] + red[2 * t + 1]) * (1.f / 128.f) + EPSN);
      const size_t row = (size_t)MP + b * 4 + t;
      const float y = o * rstd * F.norm_lin[v] * bf2f(F.GTL[row * 512 + h * 128 + v]);
      F.OMIX[row * 1024 + h * 128 + v] = (bf16)f2bf(y); }
    __syncthreads();
}
__device__ __forceinline__ float red16x4(float d0, float d1, float d2, float d3, int lane) {
    const bool o1 = lane & 1, o2 = lane & 2;
    const float s0 = o1 ? d0 : d2, s1 = o1 ? d1 : d3, k0 = o1 ? d2 : d0, k1 = o1 ? d3 : d1;
    const float a0 = k0 + __shfl_xor(s0, 1), a1 = k1 + __shfl_xor(s1, 1);
    const float s = o2 ? a0 : a1, kk = o2 ? a1 : a0;
    float r = kk + __shfl_xor(s, 2);
    r += __shfl_xor(r, 4); r += __shfl_xor(r, 8);
    return r;
}
__device__ __forceinline__ void sa_unit(Frame& F, int unit) {
    const int j = unit & 7, b = unit >> 3, tid = F.tid, lane = F.lane;
    LAS float* lg = (LAS float*)F.lds;
    LAS float* red = lg + 8192;
    LAS float* ksum = red + 2048;
    const int ps = tid >> 7, hh = (tid & 127) >> 4, d4 = tid & 15;
    float qv[4][4];
#pragma unroll
    for (int q = 0; q < 4; ++q) { const uint2 w = *(const uint2*)(F.QA + ((size_t)MP + b * 4 + q) * 512 + hh * 64 + 4 * d4);
        qv[q][0] = bflo(w.x); qv[q][1] = bfhi(w.x); qv[q][2] = bflo(w.y); qv[q][3] = bfhi(w.y); }
    const int pg0 = F.page_table[b * 16 + 2 * j], pg1 = F.page_table[b * 16 + 2 * j + 1];
    const int myq = 2 * (lane & 1) + ((lane >> 1) & 1);
    f32x4 ks = {0.f, 0.f, 0.f, 0.f};
    for (int it0 = 0; it0 < 64; it0 += 8) {
        f32x4 kk[8];
#pragma unroll
        for (int u = 0; u < 8; ++u) { const int pos = 4 * (it0 + u) + ps; const int pg = pos < 128 ? pg0 : pg1;
            kk[u] = __builtin_nontemporal_load((const f32x4*)(F.cache_k + ((size_t)pg * 128 + (pos & 127)) * 512 + hh * 64 + 4 * d4)); }
#pragma unroll
        for (int u = 0; u < 8; ++u) { const int pos = 4 * (it0 + u) + ps; ks += kk[u];
            float d[4];
#pragma unroll
            for (int q = 0; q < 4; ++q) d[q] = (qv[q][0] * kk[u].x + qv[q][1] * kk[u].y) + (qv[q][2] * kk[u].z + qv[q][3] * kk[u].w);
            const float r = red16x4(d[0], d[1], d[2], d[3], lane);
            if (d4 < 4) lg[(hh * 4 + myq) * 256 + pos] = r; }
    }
    *(LAS f32x4*)(red + ps * 512 + hh * 64 + 4 * d4) = ks;
    __syncthreads();
    ksum[tid] = (red[tid] + red[512 + tid]) + (red[1024 + tid] + red[1536 + tid]);
    __syncthreads();
    { const f32x4 kssum = *(const LAS f32x4*)(ksum + hh * 64 + 4 * d4); float d[4];
#pragma unroll
      for (int q = 0; q < 4; ++q) d[q] = (qv[q][0] * kssum.x + qv[q][1] * kssum.y) + (qv[q][2] * kssum.z + qv[q][3] * kssum.w);
      const float r = red16x4(d[0], d[1], d[2], d[3], lane);
      if (ps == 0 && d4 < 4) F.GATE[((size_t)(b * 8 + hh) * 4 + myq) * 8 + j] = r; }
#pragma unroll
    for (int i = 0; i < 16; ++i) { const int idx = tid + 512 * i, hq = idx >> 8, pos = idx & 255; const int dist = PASTLEN + (hq & 3) - (256 * j + pos);
        F.LOG[((size_t)(b * 32 + hq) * 8 + j) * 256 + pos] = lg[idx] + F.TAB[(hq >> 2) * 4096 + dist]; }
    __syncthreads();
}

__device__ __forceinline__ void hb_scan(Frame& F) {
    const int gt = F.bid * NTHR + F.tid, NGT = F.G * NTHR;
    for (int item = gt; item < 16 * 8192; item += NGT) {
        const int bh = item >> 13, e2 = item & 8191, k = e2 >> 6, v = (e2 & 63) * 2;
        f32x2 S = {0.f, 0.f};
        for (int c0 = 0; c0 < 64; c0 += 8) {
            f32x2 l[8]; float d[8];
#pragma unroll
            for (int u = 0; u < 8; ++u) { const size_t un = (size_t)bh * 64 + c0 + u; l[u] = *(const f32x2*)(F.L + (un * 128 + k) * 128 + v); d[u] = F.DC[un * 128 + k]; }
#pragma unroll
            for (int u = 0; u < 8; ++u) { const size_t un = (size_t)bh * 64 + c0 + u;
                *(unsigned*)(F.SC + (un * 128 + k) * 128 + v) = pg8::cvt_pk_bf16(S.x, S.y);
                S = S * d[u] + l[u]; }
        }
        *(f32x2*)(F.out + O_SP + ((size_t)bh * 128 + k) * 128 + v) = S;
    }
}
__device__ __forceinline__ void sb_unit(Frame& F, int unit) {
    const int j = unit & 7, b = unit >> 3, tid = F.tid, lane = F.lane, w = F.wave;
    LAS float* p = (LAS float*)F.lds;
    LAS float* red = p + 8192;
    LAS unsigned* selw = (LAS unsigned*)(red + 8192);
    if (tid < 32) { float g[8];
#pragma unroll
        for (int i = 0; i < 8; ++i) g[i] = F.GATE[(size_t)(b * 32 + tid) * 8 + i];
        selw[tid] = (top3mask8(g) >> j) & 1u; }
    __syncthreads();
#pragma unroll
    for (int i = 0; i < 4; ++i) { const int hq = 4 * w + i;
        if (selw[hq]) { const float* lp = F.LOG + ((size_t)(b * 32 + hq) * 8 + j) * 256 + lane; float x[4];
#pragma unroll
            for (int u = 0; u < 4; ++u) x[u] = lp[64 * u];
            const float m = wave_max(fmaxf(fmaxf(x[0], x[1]), fmaxf(x[2], x[3]))); float s = 0.f;
#pragma unroll
            for (int u = 0; u < 4; ++u) { x[u] = ex2(x[u] - m); s += x[u]; p[hq * 256 + lane + 64 * u] = x[u]; }
            s = wave_sum(s);
            if (lane == 0) { F.ML[((size_t)(b * 32 + hq) * 8 + j) * 2] = m; F.ML[((size_t)(b * 32 + hq) * 8 + j) * 2 + 1] = s; }
        } else {
#pragma unroll
            for (int u = 0; u < 4; ++u) p[hq * 256 + lane + 64 * u] = 0.f; }
    }
    __syncthreads();
    const int ps = tid >> 7, hh = (tid & 127) >> 4, d4 = tid & 15;
    const bool hsel = (selw[hh * 4] | selw[hh * 4 + 1] | selw[hh * 4 + 2] | selw[hh * 4 + 3]) != 0u;
    f32x4 acc[4];
#pragma unroll
    for (int q = 0; q < 4; ++q) acc[q] = (f32x4){0.f, 0.f, 0.f, 0.f};
    if (hsel) {
        const int pg0 = F.page_table[b * 16 + 2 * j], pg1 = F.page_table[b * 16 + 2 * j + 1];
        for (int it0 = 0; it0 < 64; it0 += 8) {
            f32x4 vv[8];
#pragma unroll
            for (int u = 0; u < 8; ++u) { const int pos = 4 * (it0 + u) + ps; const int pg = pos < 128 ? pg0 : pg1;
                vv[u] = __builtin_nontemporal_load((const f32x4*)(F.cache_v + ((size_t)pg * 128 + (pos & 127)) * 512 + hh * 64 + 4 * d4)); }
#pragma unroll
            for (int u = 0; u < 8; ++u) { const int pos = 4 * (it0 + u) + ps;
#pragma unroll
                for (int q = 0; q < 4; ++q) acc[q] += vv[u] * p[(hh * 4 + q) * 256 + pos]; }
        }
    }
#pragma unroll
    for (int q = 0; q < 4; ++q) *(LAS f32x4*)(red + ((ps * 32 + hh * 4 + q) * 64) + 4 * d4) = acc[q];
    __syncthreads();
#pragma unroll
    for (int i = 0; i < 4; ++i) { const int idx = tid + 512 * i, hq = idx >> 6, d = idx & 63;
        F.OPART[((size_t)(b * 32 + hq) * 8 + j) * 64 + d] = (red[hq * 64 + d] + red[(32 + hq) * 64 + d]) + (red[(64 + hq) * 64 + d] + red[(96 + hq) * 64 + d]); }
    __syncthreads();
}

__device__ __forceinline__ void hc_unit(Frame& F, int unit) {
    const int c = unit & 63, bh = unit >> 6, h = bh & 3, b = bh >> 2;
    const size_t r0 = (size_t)b * SEQ + c * 64;
    LAS float* tot = (LAS float*)F.lds;
    LAS bf16* Qt = (LAS bf16*)(F.lds + 2048);
    LAS bf16* Qh = (LAS bf16*)(F.lds + 2048 + 17408);
    LAS bf16* Kt = (LAS bf16*)(F.lds + 2048 + 2 * 17408);
    LAS bf16* Vs = (LAS bf16*)(F.lds + 2048 + 3 * 17408);
    LAS bf16* Ss = (LAS bf16*)(F.lds + 2048 + 3 * 17408 + 18432);
    LAS float* Ob = (LAS float*)(F.lds + 2048);
    const int tid = F.tid, lane = F.lane, k = tid & 127, tg = tid >> 7, hi = lane >> 5;
    const float* gp = F.GL + (r0 + tg * 16) * 512 + h * 128 + k;
    const bf16* qp = F.QL + (r0 + tg * 16) * 512 + h * 128 + k;
    float gv[16], cs[16], qv[16]; float run = 0.f;
#pragma unroll
    for (int i = 0; i < 16; ++i) { gv[i] = gp[(size_t)i * 512]; qv[i] = bf2f(qp[(size_t)i * 512]); }
    v4u vreg[2], sreg[4];
#pragma unroll
    for (int i = 0; i < 2; ++i) { const int idx = tid + 512 * i, s = idx >> 4, ch = idx & 15; vreg[i] = *(const v4u*)(F.VL + (r0 + s) * 512 + h * 128 + ch * 8); }
#pragma unroll
    for (int i = 0; i < 4; ++i) { const int idx = tid + 512 * i, kr = idx >> 4, ch = idx & 15; sreg[i] = *(const v4u*)(F.SC + ((size_t)unit * 128 + kr) * 128 + ch * 8); }
#pragma unroll
    for (int i = 0; i < 16; ++i) { run += gv[i]; cs[i] = run; }
    tot[tg * 128 + k] = run;
    __syncthreads();
    const float t0 = tot[k], t1 = tot[128 + k], t2 = tot[256 + k];
    const float prefix = (tg > 0 ? t0 : 0.f) + (tg > 1 ? t1 : 0.f) + (tg > 2 ? t2 : 0.f), rref = t0 + t1;
#pragma unroll
    for (int i = 0; i < 16; ++i) { const float bi = prefix + cs[i], kk = 1.0f - __expf(gv[i]); const int t = tg * 16 + i;
        Qt[t * 136 + k] = (bf16)f2bf(qv[i] * __expf(bi - rref)); Qh[t * 136 + k] = (bf16)f2bf(qv[i] * __expf(bi)); Kt[t * 136 + k] = (bf16)f2bf(kk * __expf(rref - bi)); }
#pragma unroll
    for (int i = 0; i < 2; ++i) { const int idx = tid + 512 * i, s = idx >> 4, ch = idx & 15; *(LAS v4u*)(Vs + s * 144 + ch * 8) = vreg[i]; }
#pragma unroll
    for (int i = 0; i < 4; ++i) { const int idx = tid + 512 * i, kr = idx >> 4, ch = idx & 15; *(LAS v4u*)(Ss + kr * 144 + ch * 8) = sreg[i]; }
    __syncthreads();
    const int w = F.wave, tt = w >> 2, vt = w & 3, g4 = lane >> 4, i16 = lane & 15, l31 = lane & 31;
    f32x16 o = {};
    for (int st = 0; st <= tt; ++st) {
        f32x16 a = {};
#pragma unroll
        for (int kk = 0; kk < 8; ++kk) {
            const bf16x8 A = *(const LAS bf16x8*)(Kt + (32 * st + l31) * 136 + 16 * kk + 8 * hi);
            const bf16x8 B = *(const LAS bf16x8*)(Qt + (32 * tt + l31) * 136 + 16 * kk + 8 * hi);
            a = __builtin_amdgcn_mfma_f32_32x32x16_bf16(A, B, a, 0, 0, 0); }
        if (st == tt) {
#pragma unroll
            for (int r = 0; r < 16; ++r) if (crow(r, hi) > l31) a[r] = 0.f; }
#pragma unroll
        for (int s2 = 0; s2 < 2; ++s2) {
            const bf16x8 pa = pack8(a[8 * s2], a[8 * s2 + 1], a[8 * s2 + 2], a[8 * s2 + 3], a[8 * s2 + 4], a[8 * s2 + 5], a[8 * s2 + 6], a[8 * s2 + 7]);
            const int rowb = 32 * st + 16 * s2 + 4 * (g4 >> 1) + (i16 >> 2), col = 32 * vt + 16 * (g4 & 1) + 4 * (i16 & 3);
            const bf16x8 B = trpair(Vs + rowb * 144 + col, Vs + (rowb + 8) * 144 + col);
            o = __builtin_amdgcn_mfma_f32_32x32x16_bf16(pa, B, o, 0, 0, 0); }
    }
#pragma unroll
    for (int kk = 0; kk < 8; ++kk) {
        const bf16x8 A = *(const LAS bf16x8*)(Qh + (32 * tt + l31) * 136 + 16 * kk + 8 * hi);
        const int rowb = 16 * kk + 8 * (g4 >> 1) + (i16 >> 2), col = 32 * vt + 16 * (g4 & 1) + 4 * (i16 & 3);
        const bf16x8 B = trpair(Ss + rowb * 144 + col, Ss + (rowb + 4) * 144 + col);
        o = __builtin_amdgcn_mfma_f32_32x32x16_bf16(A, B, o, 0, 0, 0); }
    __syncthreads();
#pragma unroll
    for (int r = 0; r < 16; ++r) Ob[(32 * tt + crow(r, hi)) * 132 + 32 * vt + l31] = o[r];
    __syncthreads();
    { const int t = tid >> 3, vc = (tid & 7) * 16; float x[16]; float ss = 0.f;
#pragma unroll
      for (int i = 0; i < 16; i += 4) { const f32x4 q = *(const LAS f32x4*)(Ob + t * 132 + vc + i); x[i] = q.x; x[i + 1] = q.y; x[i + 2] = q.z; x[i + 3] = q.w; ss += (q.x * q.x + q.y * q.y) + (q.z * q.z + q.w * q.w); }
      ss += __shfl_xor(ss, 1); ss += __shfl_xor(ss, 2); ss += __shfl_xor(ss, 4);
      const float rstd = 1.0f / sqrtf(ss * (1.f / 128.f) + EPSN);
      const v4u g0 = *(const v4u*)(F.GTL + (r0 + t) * 512 + h * 128 + vc), g1 = *(const v4u*)(F.GTL + (r0 + t) * 512 + h * 128 + vc + 8);
      const unsigned gw[8] = {g0.x, g0.y, g0.z, g0.w, g1.x, g1.y, g1.z, g1.w};
      unsigned ow[8];
#pragma unroll
      for (int i = 0; i < 8; ++i) { const float a = x[2 * i] * rstd * F.norm_lin[vc + 2 * i] * bflo(gw[i]), bq = x[2 * i + 1] * rstd * F.norm_lin[vc + 2 * i + 1] * bfhi(gw[i]); ow[i] = pg8::cvt_pk_bf16(a, bq); }
      bf16* op = F.OMIX + (r0 + t) * 1024 + h * 128 + vc;
      *(v4u*)op = (v4u){ow[0], ow[1], ow[2], ow[3]}; *(v4u*)(op + 8) = (v4u){ow[4], ow[5], ow[6], ow[7]}; }
    __syncthreads();
}
__device__ __forceinline__ void pa_unit(Frame& F, int b, int h, int o) {
    constexpr int KSZ = 64 * 72;
    LAS bf16* Ks = (LAS bf16*)F.lds;
    LAS bf16* Vs = Ks + 2 * KSZ;
    LAS float* T2 = (LAS float*)(F.lds + 4 * KSZ * 2);
    LAS float* km = T2 + 4096;
    LAS unsigned* sel = (LAS unsigned*)(km + 1024);
    const int tid = F.tid, lane = F.lane, w = F.wave, hi = lane >> 5, l31 = lane & 31, g4 = lane >> 4, i16 = lane & 15;
    const size_t rb = (size_t)b * SEQ;
    for (int i = tid; i < 4096; i += NTHR) T2[i] = F.TAB[h * 4096 + i];
    for (int i = tid; i < 1024; i += NTHR) { const int j = i >> 6, d = i & 63; const float* kp = F.KMP + ((size_t)(b * 64 + 4 * j)) * 512 + h * 64 + d;
        km[i] = (kp[0] + kp[512]) + (kp[1024] + kp[1536]); }
    __syncthreads();
    if (tid < 256) {
        const bf16* qp = F.QA + (rb + 256 * o + tid) * 512 + h * 64;
        float qf[64];
#pragma unroll
        for (int i = 0; i < 8; ++i) { const v4u q = *(const v4u*)(qp + 8 * i); qf[8 * i] = bflo(q.x); qf[8 * i + 1] = bfhi(q.x); qf[8 * i + 2] = bflo(q.y); qf[8 * i + 3] = bfhi(q.y);
            qf[8 * i + 4] = bflo(q.z); qf[8 * i + 5] = bfhi(q.z); qf[8 * i + 6] = bflo(q.w); qf[8 * i + 7] = bfhi(q.w); }
        float b1 = -INFINITY, b2 = -INFINITY, b3 = -INFINITY; int i1 = -1, i2 = -1, i3 = -1;
        for (int j = 0; j < o; ++j) { float g = 0.f;
#pragma unroll
            for (int d = 0; d < 64; d += 4) { const f32x4 kq = *(const LAS f32x4*)(km + j * 64 + d); g += (qf[d] * kq.x + qf[d + 1] * kq.y) + (qf[d + 2] * kq.z + qf[d + 3] * kq.w); }
            if (g > b1) { b3 = b2; i3 = i2; b2 = b1; i2 = i1; b1 = g; i1 = j; } else if (g > b2) { b3 = b2; i3 = i2; b2 = g; i2 = j; } else if (g > b3) { b3 = g; i3 = j; } }
        sel[tid] = (i1 >= 0 ? 1u << i1 : 0u) | (i2 >= 0 ? 1u << i2 : 0u) | (i3 >= 0 ? 1u << i3 : 0u);
    }
    const int qloc = 32 * w + l31; const size_t qrow = rb + 256 * o + qloc;
    bf16x8 qf4[4];
#pragma unroll
    for (int d0 = 0; d0 < 4; ++d0) qf4[d0] = *(const bf16x8*)(F.QA + qrow * 512 + h * 64 + 16 * d0 + 8 * hi);
    const int ntiles = 4 + 4 * o;
    const int skv = tid >> 3, sch = tid & 7;
    v4u kreg, vreg;
    { const int kvb = 256 * o; kreg = *(const v4u*)(F.KA + (rb + kvb + skv) * 512 + h * 64 + sch * 8); vreg = *(const v4u*)(F.VA + (rb + kvb + skv) * 512 + h * 64 + sch * 8); }
    *(LAS v4u*)(Ks + skv * 72 + sch * 8) = kreg; *(LAS v4u*)(Vs + skv * 72 + sch * 8) = vreg;
    __syncthreads();
    const unsigned selm = sel[qloc];
    const int qpos = 256 * o + qloc;
    float m = NEGBIG, l = 0.f; f32x16 oa0 = {}, oa1 = {};
    for (int ti = 0; ti < ntiles; ++ti) {
        const int buf = ti & 1;
        if (ti + 1 < ntiles) { const int tn = ti + 1, kvn = tn < 4 ? 256 * o + 64 * tn : 64 * (tn - 4);
            kreg = *(const v4u*)(F.KA + (rb + kvn + skv) * 512 + h * 64 + sch * 8); vreg = *(const v4u*)(F.VA + (rb + kvn + skv) * 512 + h * 64 + sch * 8); }
        const bool own = ti < 4; const int kvb = own ? 256 * o + 64 * ti : 64 * (ti - 4); const int jb = own ? 0 : (ti - 4) >> 2;
        const bool rowsel = own || ((selm >> jb) & 1u);
        const bool active = own ? (ti <= (w >> 1)) : (__any(rowsel) != 0);
        if (active) {
            const LAS bf16* Kb = Ks + buf * KSZ; const LAS bf16* Vb = Vs + buf * KSZ;
            f32x16 p0 = {}, p1 = {};
#pragma unroll
            for (int d0 = 0; d0 < 4; ++d0) {
                const bf16x8 a0 = *(const LAS bf16x8*)(Kb + l31 * 72 + 16 * d0 + 8 * hi), a1 = *(const LAS bf16x8*)(Kb + (32 + l31) * 72 + 16 * d0 + 8 * hi);
                p0 = __builtin_amdgcn_mfma_f32_32x32x16_bf16(a0, qf4[d0], p0, 0, 0, 0); p1 = __builtin_amdgcn_mfma_f32_32x32x16_bf16(a1, qf4[d0], p1, 0, 0, 0); }
            const int dbase = qpos - kvb - 4 * hi;
            const bool far = (256 * o + 32 * w) - (kvb + 63) >= 800;
            if (far) { const float cb = T2[4095];
#pragma unroll
                for (int r = 0; r < 16; ++r) { p0[r] = rowsel ? p0[r] + cb : NEGBIG; p1[r] = rowsel ? p1[r] + cb : NEGBIG; }
            } else {
#pragma unroll
                for (int r = 0; r < 16; ++r) { const int dd0 = dbase - ((r & 3) + 8 * (r >> 2)), dd1 = dd0 - 32;
                    const float t0 = T2[dd0 > 0 ? dd0 : 0], t1 = T2[dd1 > 0 ? dd1 : 0];
                    p0[r] = (rowsel && dd0 >= 0) ? p0[r] + t0 : NEGBIG; p1[r] = (rowsel && dd1 >= 0) ? p1[r] + t1 : NEGBIG; }
            }
            float mx = fmaxf(p0[0], p1[0]);
#pragma unroll
            for (int r = 1; r < 16; ++r) mx = fmaxf(mx, fmaxf(p0[r], p1[r]));
            mx = fmaxf(mx, __shfl_xor(mx, 32));
            const float mn = fmaxf(m, mx), alpha = ex2(m - mn); m = mn;
            float rs = 0.f;
#pragma unroll
            for (int r = 0; r < 16; ++r) { p0[r] = ex2(p0[r] - mn); p1[r] = ex2(p1[r] - mn); rs += p0[r] + p1[r]; }
            l = l * alpha + rs;
#pragma unroll
            for (int r = 0; r < 16; ++r) { oa0[r] *= alpha; oa1[r] *= alpha; }
            const bf16x8 pb0 = pack8(p0[0], p0[1], p0[2], p0[3], p0[4], p0[5], p0[6], p0[7]), pb1 = pack8(p0[8], p0[9], p0[10], p0[11], p0[12], p0[13], p0[14], p0[15]);
            const bf16x8 pb2 = pack8(p1[0], p1[1], p1[2], p1[3], p1[4], p1[5], p1[6], p1[7]), pb3 = pack8(p1[8], p1[9], p1[10], p1[11], p1[12], p1[13], p1[14], p1[15]);
#define PA_PV(s, PB) do { const int rowb = 16 * (s) + 4 * (g4 >> 1) + (i16 >> 2), col = 16 * (g4 & 1) + 4 * (i16 & 3); \
                const bf16x8 va0 = trpair(Vb + rowb * 72 + col, Vb + (rowb + 8) * 72 + col), va1 = trpair(Vb + rowb * 72 + 32 + col, Vb + (rowb + 8) * 72 + 32 + col); \
                oa0 = __builtin_amdgcn_mfma_f32_32x32x16_bf16(va0, PB, oa0, 0, 0, 0); oa1 = __builtin_amdgcn_mfma_f32_32x32x16_bf16(va1, PB, oa1, 0, 0, 0); } while (0)
            PA_PV(0, pb0); PA_PV(1, pb1); PA_PV(2, pb2); PA_PV(3, pb3);
#undef PA_PV
        }
        if (ti + 1 < ntiles) { *(LAS v4u*)(Ks + (buf ^ 1) * KSZ + skv * 72 + sch * 8) = kreg; *(LAS v4u*)(Vs + (buf ^ 1) * KSZ + skv * 72 + sch * 8) = vreg; }
        __syncthreads();
    }
    l += __shfl_xor(l, 32);
    const float inv = 1.0f / l;
#pragma unroll
    for (int dh = 0; dh < 2; ++dh)
#pragma unroll
        for (int rg = 0; rg < 4; ++rg) { const int d0 = 32 * dh + 8 * rg + 4 * hi;
            const uint2 gw = *(const uint2*)(F.GTA + qrow * 512 + h * 64 + d0);
            const float x0 = (dh ? oa1[4 * rg] : oa0[4 * rg]) * inv * bflo(gw.x), x1 = (dh ? oa1[4 * rg + 1] : oa0[4 * rg + 1]) * inv * bfhi(gw.x);
            const float x2 = (dh ? oa1[4 * rg + 2] : oa0[4 * rg + 2]) * inv * bflo(gw.y), x3 = (dh ? oa1[4 * rg + 3] : oa0[4 * rg + 3]) * inv * bfhi(gw.y);
            uint2 ow; ow.x = pg8::cvt_pk_bf16(x0, x1); ow.y = pg8::cvt_pk_bf16(x2, x3);
            *(uint2*)(F.OMIX + qrow * 1024 + 512 + h * 64 + d0) = ow; }
    __syncthreads();
}
__device__ __forceinline__ void sc_item(Frame& F, int item) {
    const int q = item & 3, h = (item >> 2) & 7, b = item >> 5, lane = F.lane;
    const size_t row = (size_t)MP + b * 4 + q;
    float g[8];
#pragma unroll
    for (int i = 0; i < 8; ++i) g[i] = F.GATE[(size_t)item * 8 + i];
    const unsigned mask = top3mask8(g);
    const float qd = bf2f(F.QA[row * 512 + h * 64 + lane]);
    float s[4], vd[4]; float M = NEGBIG;
#pragma unroll
    for (int i = 0; i < 4; ++i) { const size_t kr = (size_t)MP + b * 4 + i; s[i] = NEGBIG; vd[i] = 0.f;
        if (i <= q) { s[i] = wave_sum(qd * bf2f(F.KA[kr * 512 + h * 64 + lane])) + F.TAB[h * 4096 + (q - i)]; vd[i] = bf2f(F.VA[kr * 512 + h * 64 + lane]); M = fmaxf(M, s[i]); } }
    float mj[8], lj[8];
#pragma unroll
    for (int j = 0; j < 8; ++j) { mj[j] = NEGBIG; lj[j] = 0.f; if ((mask >> j) & 1u) { mj[j] = F.ML[((size_t)item * 8 + j) * 2]; lj[j] = F.ML[((size_t)item * 8 + j) * 2 + 1]; M = fmaxf(M, mj[j]); } }
    float num = 0.f, den = 0.f;
#pragma unroll
    for (int i = 0; i < 4; ++i) if (i <= q) { const float e = ex2(s[i] - M); num += e * vd[i]; den += e; }
#pragma unroll
    for (int j = 0; j < 8; ++j) if ((mask >> j) & 1u) { const float e = ex2(mj[j] - M); num += e * F.OPART[((size_t)item * 8 + j) * 64 + lane]; den += e * lj[j]; }
    const float y = num / den * bf2f(F.GTA[row * 512 + h * 64 + lane]);
    F.OMIX[row * 1024 + 512 + h * 64 + lane] = (bf16)f2bf(y);
}

__device__ __forceinline__ void p6_row(Frame& F, int m) {
    const GAS f32x4* orow = (const GAS f32x4*)(F.O2 + (size_t)m * DM) + F.lane; const GAS f32x4* gr = (const GAS f32x4*)F.norm_post + F.lane;
    const GAS f32x4* xr = (const GAS f32x4*)(m < MP ? F.xp + (size_t)m * DM : F.xs + (size_t)(m - MP) * DM) + F.lane;
    GAS f32x4* yr = (GAS f32x4*)(m < MP ? F.out + O_YP + (size_t)m * DM : F.out + O_YS + (size_t)(m - MP) * DM) + F.lane;
    f32x4 v[4]; float s = 0.f;
#pragma unroll
    for (int j = 0; j < 4; ++j) { v[j] = orow[64 * j]; s += (v[j].x * v[j].x + v[j].y * v[j].y) + (v[j].z * v[j].z + v[j].w * v[j].w); }
    const float rstd = 1.0f / sqrtf(wave_sum(s) * (1.f / DM) + EPSN);
#pragma unroll
    for (int j = 0; j < 4; ++j) yr[64 * j] = xr[64 * j] + v[j] * rstd * gr[64 * j];
}

#ifndef MK_PER_PHASE
#define MK_PER_PHASE 0
#endif
constexpr int N_PHASES = 7;
struct Args { const void* in[13]; float* out; unsigned char* ws; int ph_lo, ph_hi; };
__global__ void __launch_bounds__(NWAVES * 64, 2) hymba_fwd(Args args) {
    extern __shared__ __attribute__((aligned(16))) unsigned char lds[];
    Frame F;
    F.lds = (LAS unsigned char*)lds;
    F.MISC = (volatile LAS unsigned*)(F.lds + MISC_OFF);
    F.tid = threadIdx.x; F.lane = F.tid & 63; F.wave = __builtin_amdgcn_readfirstlane(F.tid >> 6);
    F.G = gridDim.x; F.bid = blockIdx.x;
    unsigned char* ws = args.ws;
    F.ctl = (gu32*)(ws + WS_CTL);
    F.xp = (const float*)args.in[0]; F.xs = (const float*)args.in[1]; F.cache_k = (const float*)args.in[2]; F.cache_v = (const float*)args.in[3]; F.state = (const float*)args.in[4];
    F.page_table = (const int*)args.in[5]; F.w_in = (const float*)args.in[6]; F.w_out = (const float*)args.in[7]; F.norm_pre = (const float*)args.in[8]; F.norm_post = (const float*)args.in[9];
    F.norm_lin = (const float*)args.in[10]; F.llb = (const float*)args.in[11]; F.rel_bias = (const float*)args.in[12]; F.out = args.out;
    F.WIN = (bf16*)(ws + WS_WIN); F.WOUT = (bf16*)(ws + WS_WOUT); F.H = (bf16*)(ws + WS_H); F.QL = (bf16*)(ws + WS_QL); F.VL = (bf16*)(ws + WS_VL); F.GTL = (bf16*)(ws + WS_GTL);
    F.QA = (bf16*)(ws + WS_QA); F.KA = (bf16*)(ws + WS_KA); F.VA = (bf16*)(ws + WS_VA); F.GTA = (bf16*)(ws + WS_GTA); F.SC = (bf16*)(ws + WS_SC); F.OMIX = (bf16*)(ws + WS_OMIX);
    F.TAB = (float*)(ws + WS_TAB); F.LB = (float*)(ws + WS_LB); F.KMP = (float*)(ws + WS_KMP); F.GATE = (float*)(ws + WS_GATE); F.ML = (float*)(ws + WS_ML); F.DC = (float*)(ws + WS_DC);
    F.GL = (float*)(ws + WS_GL); F.L = (float*)(ws + WS_L); F.LOG = (float*)(ws + WS_LOG); F.OPART = (float*)(ws + WS_OPART); F.O2 = (float*)(ws + WS_O2);
    for (int u = F.tid; u < (LDS_BYTES - LDSCTL_OFF) / 4; u += NWAVES * 64) ((LAS unsigned*)(F.lds + LDSCTL_OFF))[u] = 0u;
    __syncthreads();
    XcdBarrier bar; bar.bar = (unsigned*)(F.ctl + CW_BAR); bar.x = 0; bar.st = nullptr;
    if (!MK_PER_PHASE) bar = xcd_barrier_post((unsigned*)(F.ctl + CW_BAR), F.MISC + 8);
#define GRID_BAR() do { if (!MK_PER_PHASE) xcd_barrier(bar); } while (0)
    const int lo = args.ph_lo, hi = args.ph_hi;
#define IN(k) (lo <= (k) && (k) < hi)
#define BOTH(k) (IN(k) && IN((k) + 1))
    const int bid = F.bid, G = F.G;
    if (IN(0)) { p0_prologue(F); if (BOTH(0)) GRID_BAR(); }
    if (IN(1)) {
        pg8::Gemm g{F.H, F.WIN, MROWS, DIN, DM}; pg8::StaticOrder S; S.init(MROWS, DIN, G, bid);
        Epi1 E{ws, F.out, F.LB};
        pg8::gemm_phase<Epi1, pg8::StaticOrder, true, true>(F.lds + RING_OFF, g, S, E);
        if (BOTH(1)) GRID_BAR();
    }
    if (IN(2)) {
        for (int u = bid; u < 1024; u += G) ha_unit(F, u);
        for (int u = bid; u < 256; u += G) km_unit(F, u);
        for (int u = bid; u < 512; u += G) sh_unit(F, u);
        for (int u = bid; u < 1024; u += G) sa_unit(F, u);
        if (BOTH(2)) GRID_BAR();
    }
    if (IN(3)) {
        hb_scan(F);
        for (int u = bid; u < 1024; u += G) sb_unit(F, u);
        if (BOTH(3)) GRID_BAR();
    }
    if (IN(4)) {
        for (int u = bid; u < 1024; u += G) hc_unit(F, u);
        for (int u = bid; u < 256; u += G) { const int bh = u >> 3, s = u & 7; pa_unit(F, bh >> 3, bh & 7, s); pa_unit(F, bh >> 3, bh & 7, 15 - s); }
        for (int it = bid * NWAVES + F.wave; it < 4096; it += G * NWAVES) sc_item(F, it);
        if (BOTH(4)) GRID_BAR();
    }
    if (IN(5)) {
        pg8::Gemm g{F.OMIX, F.WOUT, MROWS, DM, DM}; pg8::StaticOrder S; S.init(MROWS, DM, G, bid);
        Epi2 E{F.O2};
        pg8::gemm_phase<Epi2, pg8::StaticOrder, true, true>(F.lds + RING_OFF, g, S, E);
        if (BOTH(5)) GRID_BAR();
    }
    if (IN(6)) { for (int m = bid * NWAVES + F.wave; m < MROWS; m += G * NWAVES) p6_row(F, m); }
#undef IN
#undef BOTH
}

extern "C" void kernel_launch(void* const* d_in, const int* in_sizes, int n_in, void* d_out, int out_size, void* d_ws, size_t ws_size, hipStream_t stream) {
    static int grid = 0;
    if (grid == 0) {
        if (n_in != 13 || (size_t)out_size != O_END || ws_size < WS_END) { fprintf(stderr, "kernel_launch: unexpected shapes (n_in %d out %d ws %zu)\n", n_in, out_size, ws_size); grid = -1; return; }
        int dev = 0, cus = 0, per_cu = 0;
        if (hipGetDevice(&dev) != hipSuccess || hipDeviceGetAttribute(&cus, hipDeviceAttributeMultiprocessorCount, dev) != hipSuccess) { grid = -1; return; }
        if (hipFuncSetAttribute((const void*)hymba_fwd, hipFuncAttributeMaxDynamicSharedMemorySize, LDS_BYTES) != hipSuccess) { fprintf(stderr, "kernel_launch: hipFuncSetAttribute failed\n"); grid = -1; return; }
        if (hipOccupancyMaxActiveBlocksPerMultiprocessor(&per_cu, (const void*)hymba_fwd, NWAVES * 64, LDS_BYTES) != hipSuccess || per_cu < 1) { fprintf(stderr, "kernel_launch: occupancy query says %d\n", per_cu); }
        (void)hipGetLastError();
        grid = cus;
    }
    if (grid < 0) return;
    if (hipMemsetAsync((char*)d_ws + WS_CTL, 0, CTL_ZERO_BYTES, stream) != hipSuccess) return;
    Args a{};
    for (int i = 0; i < 13; ++i) a.in[i] = d_in[i];
    a.out = (float*)d_out; a.ws = (unsigned char*)d_ws;
#if MK_PER_PHASE
    for (int p = 0; p < N_PHASES; ++p) { a.ph_lo = p; a.ph_hi = p + 1; hipLaunchKernelGGL(hymba_fwd, dim3(grid), dim3(NWAVES * 64), LDS_BYTES, stream, a); }
#else
    a.ph_lo = 0; a.ph_hi = N_PHASES;
    hipLaunchKernelGGL(hymba_fwd, dim3(grid), dim3(NWAVES * 64), LDS_BYTES, stream, a);
#endif
}
```

```cpp
#define MK_PER_PHASE 0
#include <hip/hip_runtime.h>
#include <cstdio>
#include <cstdint>
#include <cmath>
namespace pg8 {
#define PG8_LAS __attribute__((address_space(3)))
typedef unsigned short bf16_t;
typedef short bf16x8 __attribute__((ext_vector_type(8)));
typedef float f32x4 __attribute__((ext_vector_type(4)));
typedef unsigned u32x4 __attribute__((ext_vector_type(4)));
constexpr int BM = 256, BK = 64, HALF = 128, HTB = HALF * BK * 2  , STAGE_BYTES = 8 * HTB, NXCD = 8, WGM = 8;

__host__ __device__ __forceinline__ int lds_byte(int r, int c) { const int st = (r >> 4) * 2 + (c >> 5), rr = r & 15, cc = c & 31, ob = rr * 64 + cc * 2; return st * 1024 + (ob ^ (((ob >> 9) & 1) << 5)); }
__host__ __device__ __forceinline__ void stage_rc(int b, int& R, int& C) { const int st = b / 1024, sb = b % 1024, swz = sb ^ (((sb >> 9) & 1) << 5); R = (st >> 1) * 16 + swz / 64; C = (st & 1) * 32 + (swz % 64) / 2; }
__host__ __device__ __forceinline__ int perm32(int rho) { const int n = rho >> 4, i = rho & 15; return 8 * (i >> 2) + 4 * n + (i & 3); }

struct Unit { int pm, pn; };
struct Gemm { const bf16_t* A; const bf16_t* Bt; int M, N, K; };

struct StaticOrder {
    int nM, nN, nwg, G, c;
    __host__ __device__ void init(int M, int N, int G_, int c_) { nM = M / BM; nN = N / BM; nwg = nM * nN; G = G_; c = c_; }
    __host__ __device__ bool next(int i, Unit& u) const {
        const long L = (long)i * G + c; if (L >= nwg) return false;
        int wgid = (int)L; { const int q = nwg / NXCD, r = nwg % NXCD, xcd = wgid % NXCD, off = wgid / NXCD; wgid = (xcd < r ? xcd * (q + 1) : r * (q + 1) + (xcd - r) * q) + off; }
        const int nig = WGM * nN, gid = wgid / nig, fm = gid * WGM, gsz = (nM - fm) < WGM ? (nM - fm) : WGM;
        u.pm = fm + ((wgid % nig) % gsz); u.pn = (wgid % nig) / gsz; return true;
    }
    __device__ __forceinline__ void a_ready(const Unit&) const {}
    __device__ __forceinline__ void done(const Unit&) const {}
};

__device__ __forceinline__ unsigned cvt_pk_bf16(float lo, float hi) { unsigned r; asm volatile("v_cvt_pk_bf16_f32 %0, %1, %2" : "=v"(r) : "v"(lo), "v"(hi)); return r; }
typedef float f32x2 __attribute__((ext_vector_type(2)));
template <class Epi, class Sched, bool ALIGN_EPI = false, bool SP2 = false>
__device__ __forceinline__ void gemm_phase(PG8_LAS unsigned char* lds, const Gemm g, const Sched& S, const Epi& E) {
    const int tid = threadIdx.x, wid = __builtin_amdgcn_readfirstlane(tid >> 6), lane = tid & 63, wr = wid >> 2, wc = wid & 3, fr = lane & 15, fq = lane >> 4;
    const int K = g.K, nt = K / BK;
    unsigned voffA[2], voffB[2];
#pragma unroll
    for (int i = 0; i < 2; ++i) { int R, C; stage_rc(tid * 16 + i * 8192, R, C); const int Rb = Epi::PERM ? ((R & ~31) + perm32(R & 31)) : R;
        voffA[i] = (unsigned)(R * K + C) * 2u; voffB[i] = (unsigned)(Rb * K + C) * 2u; }
    const size_t kstep = (size_t)(BK * 2);
    const size_t hstep = (size_t)HALF * K * 2;
    const size_t tstep = 2 * hstep;
    const unsigned ldsw = (unsigned)wid * 1024u;
    const int aoff = lds_byte(wr * 64 + fr, fq * 8), boff = lds_byte(wc * 32 + fr, fq * 8);
#define PG8_SA(b, h) (((b) * 2 + (h)) * HTB)
#define PG8_SB(b, h) ((4 + (b) * 2 + (h)) * HTB)
#define PG8_STAGE(bufoff, gbase, voff) do { _Pragma("unroll") for (int _i = 0; _i < 2; ++_i) \
        __builtin_amdgcn_global_load_lds((const unsigned*)((const char*)(gbase) + (voff)[_i]), (PG8_LAS unsigned*)(lds + (bufoff) + ldsw + _i * 8192), 16, 0, 0); } while (0)
#define PG8_LDA(dst, b, h) do { _Pragma("unroll") for (int m = 0; m < 4; ++m) _Pragma("unroll") for (int k = 0; k < 2; ++k) dst[m][k] = *(const PG8_LAS bf16x8*)(lds + PG8_SA(b, h) + aoff + m * 2048 + k * 1024); } while (0)
#define PG8_LDB(dst, b, h) do { _Pragma("unroll") for (int n = 0; n < 2; ++n) _Pragma("unroll") for (int k = 0; k < 2; ++k) dst[n][k] = *(const PG8_LAS bf16x8*)(lds + PG8_SB(b, h) + boff + n * 2048 + k * 1024); } while (0)
#define PG8_MMA(ai, bj, At, Bt) do { __builtin_amdgcn_s_setprio(1); _Pragma("unroll") for (int m = 0; m < 4; ++m) _Pragma("unroll") for (int n = 0; n < 2; ++n) _Pragma("unroll") for (int k = 0; k < 2; ++k) \
        acc[ai][bj][m][n] = __builtin_amdgcn_mfma_f32_16x16x32_bf16(Bt[n][k], At[m][k], acc[ai][bj][m][n], 0, 0, 0); __builtin_amdgcn_s_setprio(0); } while (0)
#define PG8_WAIT_V(n) asm volatile("s_waitcnt vmcnt(" #n ")" ::: "memory")
#define PG8_WAIT_L(n) asm volatile("s_waitcnt lgkmcnt(" #n ")" ::: "memory")
#define PG8_BAR __builtin_amdgcn_s_barrier()
#define PG8_SCHED __builtin_amdgcn_sched_barrier(0)
    Unit cur, nxt; int ui = 0;
    if (!S.next(0, cur)) return;
    f32x4 acc[2][2][4][2];
#pragma unroll
    for (int a = 0; a < 2; ++a)
#pragma unroll
        for (int b = 0; b < 2; ++b)
#pragma unroll
            for (int m = 0; m < 4; ++m)
#pragma unroll
                for (int n = 0; n < 2; ++n) acc[a][b][m][n] = (f32x4){0.f, 0.f, 0.f, 0.f};
    bf16x8 At[4][2], B0[2][2], B1[2][2];
    const char* cA = (const char*)g.A + (size_t)cur.pm * tstep; const char* cB = (const char*)g.Bt + (size_t)cur.pn * tstep;
    S.a_ready(cur);
    if constexpr (SP2) {
        PG8_STAGE(PG8_SB(0, 0), cB, voffB); PG8_STAGE(PG8_SB(0, 1), cB + hstep, voffB); PG8_STAGE(PG8_SA(0, 0), cA, voffA); PG8_STAGE(PG8_SA(0, 1), cA + hstep, voffA);
        if (wr == 1) PG8_BAR;
        PG8_WAIT_V(2); PG8_BAR;
        PG8_STAGE(PG8_SB(1, 0), cB + kstep, voffB); PG8_STAGE(PG8_SA(1, 0), cA + kstep, voffA); PG8_STAGE(PG8_SB(1, 1), cB + hstep + kstep, voffB);
        PG8_WAIT_V(6); PG8_BAR;
    } else {
        PG8_STAGE(PG8_SB(0, 0), cB, voffB); PG8_STAGE(PG8_SA(0, 0), cA, voffA); PG8_STAGE(PG8_SB(0, 1), cB + hstep, voffB); PG8_STAGE(PG8_SA(0, 1), cA + hstep, voffA);
        if (wr == 1) PG8_BAR;
        PG8_WAIT_V(4); PG8_BAR;
        PG8_STAGE(PG8_SB(1, 0), cB + kstep, voffB); PG8_STAGE(PG8_SA(1, 0), cA + kstep, voffA); PG8_STAGE(PG8_SB(1, 1), cB + hstep + kstep, voffB);
        PG8_WAIT_V(6); PG8_BAR;
    }
    for (;;) {
        const bool has_next = S.next(ui + 1, nxt);
        const char* nA = has_next ? (const char*)g.A + (size_t)nxt.pm * tstep : cA; const char* nB = has_next ? (const char*)g.Bt + (size_t)nxt.pn * tstep : cB;
        for (int t = 0; t < nt; t += 2) {
            const bool last = (t == nt - 2);
            const char* a1 = cA + (size_t)(t + 1) * kstep;
            const char* a2 = last ? nA : cA + (size_t)(t + 2) * kstep; const char* b2 = last ? nB : cB + (size_t)(t + 2) * kstep;
            const char* a3 = a2 + kstep; const char* b3 = b2 + kstep;
            if (last && has_next) S.a_ready(nxt);
            if constexpr (SP2) {
            PG8_LDB(B0, 0, 0); PG8_LDB(B1, 0, 1); PG8_SCHED; PG8_LDA(At, 0, 0); PG8_STAGE(PG8_SA(1, 1), a1 + hstep, voffA);
            PG8_WAIT_V(8); PG8_WAIT_L(0); PG8_BAR; PG8_MMA(0, 0, At, B0); PG8_MMA(0, 1, At, B1); PG8_BAR; PG8_SCHED;
            PG8_LDA(At, 0, 1); PG8_STAGE(PG8_SB(0, 0), b2, voffB); PG8_STAGE(PG8_SB(0, 1), b2 + hstep, voffB); PG8_STAGE(PG8_SA(0, 0), a2, voffA);
            PG8_WAIT_V(8); PG8_WAIT_L(0); PG8_BAR; PG8_MMA(1, 0, At, B0); PG8_MMA(1, 1, At, B1); PG8_BAR; PG8_SCHED;
            PG8_LDB(B0, 1, 0); PG8_LDB(B1, 1, 1); PG8_SCHED; PG8_LDA(At, 1, 0); PG8_STAGE(PG8_SA(0, 1), a2 + hstep, voffA);
            PG8_WAIT_V(8); PG8_WAIT_L(0); PG8_BAR; PG8_MMA(0, 0, At, B0); PG8_MMA(0, 1, At, B1); PG8_BAR; PG8_SCHED;
            PG8_LDA(At, 1, 1); PG8_STAGE(PG8_SB(1, 0), b3, voffB); PG8_STAGE(PG8_SB(1, 1), b3 + hstep, voffB); PG8_STAGE(PG8_SA(1, 0), a3, voffA);
            PG8_WAIT_V(8); PG8_WAIT_L(0); PG8_BAR; PG8_MMA(1, 0, At, B0); PG8_MMA(1, 1, At, B1); PG8_BAR; PG8_SCHED;
            } else {
            PG8_LDB(B0, 0, 0); PG8_SCHED; PG8_LDA(At, 0, 0); PG8_STAGE(PG8_SA(1, 1), a1 + hstep, voffA);
            PG8_WAIT_L(8); PG8_BAR; PG8_WAIT_L(0); PG8_MMA(0, 0, At, B0); PG8_BAR; PG8_SCHED;
            PG8_LDB(B1, 0, 1); PG8_STAGE(PG8_SB(0, 0), b2, voffB);
            PG8_BAR; PG8_WAIT_L(0); PG8_MMA(0, 1, At, B1); PG8_BAR;
            PG8_LDA(At, 0, 1); PG8_STAGE(PG8_SA(0, 0), a2, voffA);
            PG8_BAR; PG8_WAIT_L(0); PG8_MMA(1, 0, At, B0); PG8_BAR; PG8_SCHED;
            PG8_STAGE(PG8_SB(0, 1), b2 + hstep, voffB);
            PG8_WAIT_V(6); PG8_BAR; PG8_MMA(1, 1, At, B1); PG8_BAR;
            PG8_LDB(B0, 1, 0); PG8_SCHED; PG8_LDA(At, 1, 0); PG8_STAGE(PG8_SA(0, 1), a2 + hstep, voffA);
            PG8_WAIT_L(8); PG8_BAR; PG8_WAIT_L(0); PG8_MMA(0, 0, At, B0); PG8_BAR; PG8_SCHED;
            PG8_LDB(B1, 1, 1); PG8_STAGE(PG8_SB(1, 0), b3, voffB);
            PG8_BAR; PG8_WAIT_L(0); PG8_MMA(0, 1, At, B1); PG8_BAR;
            PG8_LDA(At, 1, 1); PG8_STAGE(PG8_SA(1, 0), a3, voffA);
            PG8_BAR; PG8_WAIT_L(0); PG8_MMA(1, 0, At, B0); PG8_BAR; PG8_SCHED;
            PG8_STAGE(PG8_SB(1, 1), b3 + hstep, voffB);
            PG8_WAIT_V(6); PG8_BAR; PG8_MMA(1, 1, At, B1); PG8_BAR;
            }
        }
        if constexpr (ALIGN_EPI) { if (wr == 0) PG8_BAR; }
        if constexpr (!Epi::AFTER_DRAIN) { E(acc, cur, wr, wc, fr, fq); S.done(cur); }
        if (!has_next) break;
#pragma unroll
        for (int a = 0; a < 2; ++a)
#pragma unroll
            for (int b = 0; b < 2; ++b)
#pragma unroll
                for (int m = 0; m < 4; ++m)
#pragma unroll
                    for (int n = 0; n < 2; ++n) acc[a][b][m][n] = (f32x4){0.f, 0.f, 0.f, 0.f};
        cur = nxt; cA = nA; cB = nB; ++ui;
        if constexpr (ALIGN_EPI) { if (wr == 1) PG8_BAR; }
    }
    PG8_WAIT_V(0);
    if constexpr (!ALIGN_EPI) { if (wr == 0) PG8_BAR; }
    PG8_BAR;
    if constexpr (Epi::AFTER_DRAIN) { E.fused(acc, cur, wr, wc, fr, fq, lds, wid, lane); S.done(cur); }
#undef PG8_SA
#undef PG8_SB
#undef PG8_STAGE
#undef PG8_LDA
#undef PG8_LDB
#undef PG8_MMA
#undef PG8_WAIT_V
#undef PG8_WAIT_L
#undef PG8_BAR
#undef PG8_SCHED
}
}

constexpr int NWAVES = 8, NTHR = 512;
constexpr int DM = 1024, SEQ = 4096, NBATCH = 4, MP = NBATCH * SEQ, DECB = 128, DECS = 4, MS = DECB * DECS, MROWS = MP + MS;
constexpr int DIN = 4096, DL = 512;
constexpr float EPSN = 1e-6f;
constexpr float LOG2E = 1.4426950408889634f;
constexpr float QSCALE = 0.125f * LOG2E;
constexpr float NEGBIG = -1.0e30f;
constexpr int PASTLEN = 2048;
constexpr size_t O_YP = 0, O_YS = O_YP + (size_t)MP * DM, O_KP = O_YS + (size_t)MS * DM, O_VP = O_KP + (size_t)MP * 512, O_SP = O_VP + (size_t)MP * 512,
                 O_KS = O_SP + (size_t)16 * 16384, O_VS = O_KS + (size_t)MS * 512, O_SS = O_VS + (size_t)MS * 512, O_END = O_SS + (size_t)512 * 16384;
constexpr size_t MiB = 1u << 20;
constexpr size_t WS_CTL = 0, CTL_ZERO_BYTES = 1 * MiB;
constexpr size_t WS_WIN = 2 * MiB, WS_WOUT = 10 * MiB, WS_TAB = 12 * MiB, WS_LB = 12 * MiB + 256 * 1024, WS_KMP = 13 * MiB, WS_GATE = 13 * MiB + 512 * 1024,
                 WS_ML = 14 * MiB, WS_DC = 15 * MiB, WS_H = 16 * MiB, WS_QL = 50 * MiB, WS_VL = 67 * MiB, WS_GTL = 84 * MiB, WS_QA = 101 * MiB, WS_KA = 118 * MiB,
                 WS_VA = 135 * MiB, WS_GTA = 152 * MiB, WS_GL = 170 * MiB, WS_L = 204 * MiB, WS_SC = 268 * MiB, WS_LOG = 300 * MiB, WS_OPART = 332 * MiB,
                 WS_OMIX = 340 * MiB, WS_O2 = 374 * MiB, WS_END = 440 * MiB;
constexpr int CW_BAR = 4096;
constexpr int RING_OFF = 0, RING_BYTES = 131072;
constexpr int LDSCTL_OFF = RING_BYTES, MISC_OFF = LDSCTL_OFF + 320;
constexpr int LDS_BYTES = 147456;

#define GAS __attribute__((address_space(1)))
#define LAS __attribute__((address_space(3)))
typedef unsigned short bf16;
typedef unsigned v4u __attribute__((ext_vector_type(4)));
typedef float f32x4 __attribute__((ext_vector_type(4)));
typedef short bf16x8 __attribute__((ext_vector_type(8)));
typedef GAS unsigned gu32;
typedef GAS unsigned long long gu64;
#define RLX_AGENT __ATOMIC_RELAXED, __HIP_MEMORY_SCOPE_AGENT
#define LDS_WAIT() asm volatile("s_waitcnt lgkmcnt(0)" ::: "memory")
#define VM_WAIT() asm volatile("s_waitcnt vmcnt(0)" ::: "memory")
__device__ __forceinline__ unsigned long long rt() { return __builtin_amdgcn_s_memrealtime(); }
__device__ __forceinline__ unsigned f2bf(float f) { unsigned u = __builtin_bit_cast(unsigned, f); return (u + 0x7fffu + ((u >> 16) & 1u)) >> 16; }
__device__ __forceinline__ unsigned pk2(float lo, float hi) { return f2bf(lo) | (f2bf(hi) << 16); }

#define XB_TMO      128
#define XB_XCNT(j)  (256  + 64 * (j))
#define XB_XSUB(j)  (1280 + 64 * (j))
#define XB_XGEN(j)  (2304 + 64 * (j))
#define XB_TOP      3328
#define XB_TOPGEN   3392
#define XCD_BAR_WORDS 3456
#define XB_SPIN_CAP (1u << 18)

__device__ __forceinline__ unsigned xb_ld(unsigned* p)              { return __hip_atomic_load(p, __ATOMIC_RELAXED, __HIP_MEMORY_SCOPE_AGENT); }
__device__ __forceinline__ unsigned xb_add(unsigned* p, unsigned v) { return __hip_atomic_fetch_add(p, v, __ATOMIC_RELAXED, __HIP_MEMORY_SCOPE_AGENT); }
__device__ __forceinline__ unsigned xb_xcc_id() { return (unsigned)__builtin_amdgcn_s_getreg((3 << 11) | 20) & 0xFu; }
#define XB_SPIN(cond, bar) do { unsigned _sp = 0; while (cond) { __builtin_amdgcn_s_sleep(1); \
    if ((++_sp & 255u) == 0u) { if (xb_ld(&(bar)[XB_TMO])) break; if (_sp > XB_SPIN_CAP) { atomicAdd(&(bar)[XB_TMO], 1u); break; } } } } while (0)

struct XcdBarrier {
    unsigned* bar; unsigned x;
    volatile LAS unsigned* st;
};

__device__ __forceinline__ XcdBarrier xcd_barrier_post(unsigned* bar, volatile LAS unsigned* st) {
    XcdBarrier b; b.bar = bar; b.x = xb_xcc_id(); b.st = st;
    if (threadIdx.x == 0) (void)xb_add(&bar[XB_XCNT(b.x)], 1u);
    return b;
}
__device__ __forceinline__ void xcd_barrier_complete(unsigned* bar, unsigned x, unsigned& nloc, unsigned& nx) {
    const unsigned G = gridDim.x * gridDim.y * gridDim.z;
    unsigned sum, cnt, mine, sp = 0u;
    for (;;) {
        sum = 0u; cnt = 0u; mine = 0u;
#pragma unroll
        for (unsigned j = 0; j < 16; ++j) { const unsigned c = xb_ld(&bar[XB_XCNT(j)]); sum += c; cnt += (c > 0u) ? 1u : 0u; mine = (j == x) ? c : mine; }
        if (sum == G) break;
        __builtin_amdgcn_s_sleep(1);
        if ((++sp & 255u) == 0u) { if (xb_ld(&bar[XB_TMO])) break; if (sp > XB_SPIN_CAP) { atomicAdd(&bar[XB_TMO], 1u); break; } }
    }
    nloc = mine > 0u ? mine : 1u; nx = cnt > 0u ? cnt : 1u;
}

__device__ __forceinline__ void xcd_barrier(const XcdBarrier& b) {
    asm volatile("s_waitcnt vmcnt(0)" ::: "memory");
    __syncthreads();
    if (threadIdx.x == 0) {
        unsigned* bar = b.bar;
        __builtin_amdgcn_s_waitcnt(0);
        unsigned nloc = b.st[0], nx = b.st[1];
        if (nloc == 0u) { xcd_barrier_complete(bar, b.x, nloc, nx); b.st[0] = nloc; b.st[1] = nx; }
        const unsigned old = xb_add(&bar[XB_XSUB(b.x)], 1u);
        const unsigned gen = old / nloc;
        if (old + 1u == (gen + 1u) * nloc) {
            __builtin_amdgcn_fence(__ATOMIC_RELEASE, "agent");
            asm volatile("s_waitcnt vmcnt(0)" ::: "memory");
            const unsigned og = xb_add(&bar[XB_TOP], 1u);
            const unsigned tg = og / nx;
            if (og + 1u == (tg + 1u) * nx) xb_add(&bar[XB_TOPGEN], 1u);
            else XB_SPIN(xb_ld(&bar[XB_TOPGEN]) == tg, bar);
            __builtin_amdgcn_fence(__ATOMIC_ACQUIRE, "agent");
            xb_add(&bar[XB_XGEN(b.x)], 1u);
            asm volatile("s_waitcnt vmcnt(0)" ::: "memory");
        } else {
            XB_SPIN(xb_ld(&bar[XB_XGEN(b.x)]) == gen, bar);
            __builtin_amdgcn_fence(__ATOMIC_ACQUIRE, "agent");
            asm volatile("s_waitcnt vmcnt(0)" ::: "memory");
        }
    }
    __syncthreads();
}
__device__ __forceinline__ void p0_transpose_item(const float* W, int K, int N, bf16* WT, int row_off, LAS float* scr, int item, int lane) {
    const int nblk = N / 32, kb = item / nblk, nb = item % nblk, k0 = 64 * kb, n0 = 32 * nb;
#pragma unroll 8
    for (int i = 0; i < 32; ++i) { const int kk = 2 * i + (lane >> 5); scr[kk * 33 + (lane & 31)] = W[(size_t)(k0 + kk) * N + n0 + (lane & 31)]; }
    LDS_WAIT(); asm volatile("" ::: "memory");
    const int c = lane & 7;
#pragma unroll
    for (int j = 0; j < 4; ++j) { const int n = (lane >> 3) + 8 * j; const LAS float* s = scr + (8 * c) * 33 + n;
        v4u o; o.x = pk2(s[0 * 33], s[1 * 33]); o.y = pk2(s[2 * 33], s[3 * 33]); o.z = pk2(s[4 * 33], s[5 * 33]); o.w = pk2(s[6 * 33], s[7 * 33]);
        *(GAS v4u*)(WT + (size_t)(row_off + n0 + n) * K + k0 + 8 * c) = o; }
    LDS_WAIT(); asm volatile("" ::: "memory");
}

typedef short v4i16_t __attribute__((ext_vector_type(4)));
typedef float f32x16 __attribute__((ext_vector_type(16)));
typedef float f32x2 __attribute__((ext_vector_type(2)));
struct Frame {
    LAS unsigned char* lds;
    volatile LAS unsigned* MISC;
    gu32* ctl;
    int tid, lane, wave, G, bid;
    const float *xp, *xs, *cache_k, *cache_v, *state, *w_in, *w_out, *norm_pre, *norm_post, *norm_lin, *llb, *rel_bias;
    const int* page_table;
    float* out;
    bf16 *WIN, *WOUT, *H, *QL, *VL, *GTL, *QA, *KA, *VA, *GTA, *SC, *OMIX;
    float *TAB, *LB, *KMP, *GATE, *ML, *DC, *GL, *L, *LOG, *OPART, *O2;
};
__device__ __forceinline__ float bf2f(bf16 b) { return __uint_as_float((unsigned)b << 16); }
__device__ __forceinline__ float bflo(unsigned w) { return __uint_as_float(w << 16); }
__device__ __forceinline__ float bfhi(unsigned w) { return __uint_as_float(w & 0xffff0000u); }
__device__ __forceinline__ float ex2(float x) { return __builtin_amdgcn_exp2f(x); }
__device__ __forceinline__ float wave_sum(float v) {
#pragma unroll
    for (int o = 1; o < 64; o <<= 1) v += __shfl_xor(v, o);
    return v;
}
__device__ __forceinline__ float wave_max(float v) {
#pragma unroll
    for (int o = 1; o < 64; o <<= 1) v = fmaxf(v, __shfl_xor(v, o));
    return v;
}
__device__ __forceinline__ int crow(int r, int hi) { return (r & 3) + 8 * (r >> 2) + 4 * hi; }
__device__ __forceinline__ bf16x8 trpair(const LAS bf16* p0, const LAS bf16* p1) {
    const v4i16_t a = __builtin_amdgcn_ds_read_tr16_b64_v4i16((LAS v4i16_t*)p0);
    const v4i16_t b = __builtin_amdgcn_ds_read_tr16_b64_v4i16((LAS v4i16_t*)p1);
    return (bf16x8){a[0], a[1], a[2], a[3], b[0], b[1], b[2], b[3]};
}
__device__ __forceinline__ bf16x8 pack8(float a0, float a1, float a2, float a3, float a4, float a5, float a6, float a7) {
    v4u w; w.x = pg8::cvt_pk_bf16(a0, a1); w.y = pg8::cvt_pk_bf16(a2, a3); w.z = pg8::cvt_pk_bf16(a4, a5); w.w = pg8::cvt_pk_bf16(a6, a7);
    return __builtin_bit_cast(bf16x8, w);
}
__device__ __forceinline__ unsigned top3mask8(const float (&g)[8]) {
    unsigned mask = 0;
#pragma unroll
    for (int n = 0; n < 3; ++n) { float bv = -INFINITY; int bi = 0;
#pragma unroll
        for (int j = 0; j < 8; ++j) { const bool free = !((mask >> j) & 1u); if (free && g[j] > bv) { bv = g[j]; bi = j; } }
        mask |= 1u << bi; }
    return mask;
}

__device__ __forceinline__ void rms_row_to_bf16(const float* xrow, const float* g, bf16* orow, int lane) {
    const GAS f32x4* xr = (const GAS f32x4*)xrow + lane; const GAS f32x4* gr = (const GAS f32x4*)g + lane;
    f32x4 v[4]; float s = 0.f;
#pragma unroll
    for (int j = 0; j < 4; ++j) { v[j] = xr[64 * j]; s += (v[j].x * v[j].x + v[j].y * v[j].y) + (v[j].z * v[j].z + v[j].w * v[j].w); }
    const float rstd = 1.0f / sqrtf(wave_sum(s) * (1.f / DM) + EPSN);
    GAS unsigned long long* o8 = (GAS unsigned long long*)orow + lane;
#pragma unroll
    for (int j = 0; j < 4; ++j) { const f32x4 gv = gr[64 * j];
        o8[64 * j] = (unsigned long long)pk2(v[j].x * rstd * gv.x, v[j].y * rstd * gv.y) | ((unsigned long long)pk2(v[j].z * rstd * gv.z, v[j].w * rstd * gv.w) << 32); }
}
__device__ __forceinline__ void p0_prologue(Frame& F) {
    LAS float* scr = (LAS float*)(F.lds + RING_OFF + F.wave * 16384);
    const int gw = F.bid * NWAVES + F.wave, NGW = F.G * NWAVES;
    constexpr int I_IN = (DM / 64) * (DIN / 32), I_OUT = (DM / 64) * (DM / 32);
    for (int it = gw; it < I_IN + I_OUT; it += NGW) {
        if (it < I_IN) p0_transpose_item(F.w_in, DM, DIN, F.WIN, 0, scr, it, F.lane);
        else p0_transpose_item(F.w_out, DM, DM, F.WOUT, 0, scr, it - I_IN, F.lane);
    }
    for (int m = gw; m < MROWS; m += NGW) {
        const float* xrow = m < MP ? F.xp + (size_t)m * DM : F.xs + (size_t)(m - MP) * DM;
        rms_row_to_bf16(xrow, F.norm_pre, F.H + (size_t)m * DM, F.lane);
    }
    const int gt = F.bid * NTHR + F.tid, NGT = F.G * NTHR;
    for (int i = gt; i < DL; i += NGT) F.LB[i] = 1.0f / (1.0f + expf(F.llb[DL + i] - F.llb[i]));
    for (int i = gt; i < 8 * 4096; i += NGT) { const int h = i >> 12, d = i & 4095; int bk;
        if (d < 16) bk = d; else { const float lg = logf((float)d / 16.0f) / 4.1588830833596715f * 16.0f; int q = 16 + (int)lg; bk = q < 31 ? q : 31; }
        F.TAB[i] = F.rel_bias[bk * 8 + h] * LOG2E; }
}

struct Epi1 {
    static constexpr bool PERM = true, AFTER_DRAIN = false;
    unsigned char* ws; float* out; const float* lb;
    __device__ __forceinline__ void operator()(const pg8::f32x4 (&acc)[2][2][4][2], const pg8::Unit& u, int wr, int wc, int fr, int fq) const {
        const int type = u.pn >> 1;
        const int cg0 = (u.pn & 1) * 256 + wc * 32 + 8 * fq;
        const int row0 = u.pm * 256 + wr * 64 + fr;
        size_t bofs = WS_QL;
        switch (type) { case 0: bofs = WS_QL; break; case 2: bofs = WS_VL; break; case 3: bofs = WS_GTL; break; case 4: bofs = WS_QA; break; case 5: bofs = WS_KA; break; case 6: bofs = WS_VA; break; case 7: bofs = WS_GTA; break; default: break; }
        bf16* dstb = (bf16*)(ws + bofs);
        float* dstf = nullptr;
        if (type == 1) dstf = (float*)(ws + WS_GL);
        if (type == 5) dstf = (u.pm < 64) ? out + O_KP : out + O_KS - (size_t)MP * 512;
        if (type == 6) dstf = (u.pm < 64) ? out + O_VP : out + O_VS - (size_t)MP * 512;
        float lbv[2][8];
#pragma unroll
        for (int bj = 0; bj < 2; ++bj)
#pragma unroll
            for (int i = 0; i < 8; ++i) lbv[bj][i] = (type == 1) ? lb[cg0 + bj * 128 + i] : 0.f;
#pragma unroll
        for (int ai = 0; ai < 2; ++ai)
#pragma unroll
            for (int m = 0; m < 4; ++m) { const size_t row = (size_t)(row0 + ai * 128 + m * 16);
#pragma unroll
                for (int bj = 0; bj < 2; ++bj) { const int col = cg0 + bj * 128;
                    float v[8];
#pragma unroll
                    for (int i = 0; i < 4; ++i) { v[i] = acc[ai][bj][m][0][i]; v[4 + i] = acc[ai][bj][m][1][i]; }
                    if (type == 0 || type == 3 || type == 7) {
#pragma unroll
                        for (int i = 0; i < 8; ++i) v[i] = v[i] / (1.0f + __expf(-v[i]));
                    } else if (type == 1) {
#pragma unroll
                        for (int i = 0; i < 8; ++i) { const float s = 1.0f / (1.0f + __expf(-v[i])); v[i] = __logf(lbv[bj][i] + (1.0f - lbv[bj][i]) * s); }
                    } else if (type == 4) {
#pragma unroll
                        for (int i = 0; i < 8; ++i) v[i] *= QSCALE;
                    }
                    if (type == 1 || type == 5 || type == 6) { float* p = dstf + row * 512 + col;
                        *(pg8::f32x4*)p = (pg8::f32x4){v[0], v[1], v[2], v[3]}; *(pg8::f32x4*)(p + 4) = (pg8::f32x4){v[4], v[5], v[6], v[7]}; }
                    if (type != 1) { pg8::u32x4 w; w.x = pg8::cvt_pk_bf16(v[0], v[1]); w.y = pg8::cvt_pk_bf16(v[2], v[3]); w.z = pg8::cvt_pk_bf16(v[4], v[5]); w.w = pg8::cvt_pk_bf16(v[6], v[7]);
                        *(pg8::u32x4*)(dstb + row * 512 + col) = w; }
                } }
    }
};
struct Epi2 {
    static constexpr bool PERM = false, AFTER_DRAIN = false;
    float* O2;
    __device__ __forceinline__ void operator()(const pg8::f32x4 (&acc)[2][2][4][2], const pg8::Unit& u, int wr, int wc, int fr, int fq) const {
        const int row0 = u.pm * 256 + wr * 64 + fr, col0 = u.pn * 256 + wc * 32 + 4 * fq;
#pragma unroll
        for (int ai = 0; ai < 2; ++ai)
#pragma unroll
            for (int m = 0; m < 4; ++m) { float* rp = O2 + (size_t)(row0 + ai * 128 + m * 16) * DM + col0;
#pragma unroll
                for (int bj = 0; bj < 2; ++bj)
#pragma unroll
                    for (int n = 0; n < 2; ++n) *(pg8::f32x4*)(rp + bj * 128 + n * 16) = acc[ai][bj][m][n]; }
    }
};

__device__ __forceinline__ void ha_unit(Frame& F, int unit) {
    const int c = unit & 63, bh = unit >> 6, h = bh & 3, b = bh >> 2;
    const size_t r0 = (size_t)b * SEQ + c * 64;
    LAS float* tot = (LAS float*)F.lds;
    LAS bf16* KhT = (LAS bf16*)(F.lds + 2048);
    LAS bf16* Vs = (LAS bf16*)(F.lds + 2048 + 18432);
    const int tid = F.tid, lane = F.lane, k = tid & 127, tg = tid >> 7, hi = lane >> 5;
    const float* gp = F.GL + (r0 + tg * 16) * 512 + h * 128 + k;
    float gv[16], cs[16]; float run = 0.f;
#pragma unroll
    for (int i = 0; i < 16; ++i) gv[i] = gp[(size_t)i * 512];
    v4u vreg[2];
#pragma unroll
    for (int i = 0; i < 2; ++i) { const int idx = tid + 512 * i, s = idx >> 4, ch = idx & 15; vreg[i] = *(const v4u*)(F.VL + (r0 + s) * 512 + h * 128 + ch * 8); }
#pragma unroll
    for (int i = 0; i < 16; ++i) { run += gv[i]; cs[i] = run; }
    tot[tg * 128 + k] = run;
    __syncthreads();
    const float t0 = tot[k], t1 = tot[128 + k], t2 = tot[256 + k], t3 = tot[384 + k];
    const float prefix = (tg > 0 ? t0 : 0.f) + (tg > 1 ? t1 : 0.f) + (tg > 2 ? t2 : 0.f), total = (t0 + t1) + (t2 + t3);
    unsigned pk[8];
#pragma unroll
    for (int i = 0; i < 16; i += 2) {
        const float a = (1.0f - __expf(gv[i])) * __expf(total - (prefix + cs[i])), bq = (1.0f - __expf(gv[i + 1])) * __expf(total - (prefix + cs[i + 1]));
        pk[i >> 1] = pg8::cvt_pk_bf16(a, bq); }
    *(LAS v4u*)(KhT + k * 72 + tg * 16) = (v4u){pk[0], pk[1], pk[2], pk[3]};
    *(LAS v4u*)(KhT + k * 72 + tg * 16 + 8) = (v4u){pk[4], pk[5], pk[6], pk[7]};
#pragma unroll
    for (int i = 0; i < 2; ++i) { const int idx = tid + 512 * i, s = idx >> 4, ch = idx & 15; *(LAS v4u*)(Vs + s * 144 + ch * 8) = vreg[i]; }
    if (tg == 0) F.DC[unit * 128 + k] = __expf(total);
    __syncthreads();
    const int w = F.wave, kt = w >> 1, g4 = lane >> 4, i16 = lane & 15;
#pragma unroll
    for (int vv = 0; vv < 2; ++vv) { const int vt = (w & 1) * 2 + vv;
        f32x16 acc = {};
#pragma unroll
        for (int ks = 0; ks < 4; ++ks) {
            const bf16x8 A = *(const LAS bf16x8*)(KhT + (32 * kt + (lane & 31)) * 72 + 16 * ks + 8 * hi);
            const int rowb = 16 * ks + 8 * (g4 >> 1) + (i16 >> 2), col = 32 * vt + 16 * (g4 & 1) + 4 * (i16 & 3);
            const bf16x8 B = trpair(Vs + rowb * 144 + col, Vs + (rowb + 4) * 144 + col);
            acc = __builtin_amdgcn_mfma_f32_32x32x16_bf16(A, B, acc, 0, 0, 0); }
        float* Lp = F.L + ((size_t)unit * 128 + 32 * kt) * 128 + 32 * vt + (lane & 31);
#pragma unroll
        for (int r = 0; r < 16; ++r) Lp[(size_t)crow(r, hi) * 128] = acc[r];
    }
    __syncthreads();
}
__device__ __forceinline__ void km_unit(Frame& F, int unit) {
    LAS float* red = (LAS float*)F.lds;
    const int tid = F.tid, c4 = tid & 127, rq = tid >> 7;
    const float* kp = F.out + O_KP + ((size_t)unit * 64 + rq * 16) * 512 + c4 * 4;
    f32x4 s = {0.f, 0.f, 0.f, 0.f};
#pragma unroll
    for (int i = 0; i < 16; ++i) s += *(const f32x4*)(kp + (size_t)i * 512);
    *(LAS f32x4*)(red + rq * 512 + c4 * 4) = s;
    __syncthreads();
    F.KMP[(size_t)unit * 512 + tid] = (red[tid] + red[512 + tid]) + (red[1024 + tid] + red[1536 + tid]);
    __syncthreads();
}
__device__ __forceinline__ void sh_unit(Frame& F, int unit) {
    const int h = unit & 3, b = unit >> 2, tid = F.tid, lane = F.lane;
    LAS float* fv = (LAS float*)F.lds;
    LAS float* kv = fv + 512; LAS float* qv = fv + 1024; LAS float* vv = fv + 1536;
    LAS float* part = fv + 2048;
    LAS float* red = part + 8192;
    { const int t = tid >> 7, k = tid & 127; const size_t row = (size_t)MP + b * 4 + t; const size_t o = row * 512 + h * 128 + k;
      const float f = __expf(F.GL[o]); fv[tid] = f; kv[tid] = 1.0f - f; qv[tid] = bf2f(F.QL[o]); vv[tid] = bf2f(F.VL[o]); }
    const int kq = tid >> 5, v4 = tid & 31;
    const size_t sbase = ((size_t)unit * 128 + 8 * kq) * 128 + 4 * v4;
    f32x4 S[8];
#pragma unroll
    for (int i = 0; i < 8; ++i) S[i] = *(const f32x4*)(F.state + sbase + (size_t)i * 128);
    __syncthreads();
#pragma unroll
    for (int t = 0; t < 4; ++t) { const f32x4 vt = *(const LAS f32x4*)(vv + t * 128 + 4 * v4); f32x4 po = {0.f, 0.f, 0.f, 0.f};
#pragma unroll
        for (int i = 0; i < 8; ++i) { const int k = 8 * kq + i; const float f = fv[t * 128 + k], kk = kv[t * 128 + k], q = qv[t * 128 + k];
            S[i] = S[i] * f + vt * kk; po += S[i] * q; }
        *(LAS f32x4*)(part + (t * 16 + kq) * 128 + 4 * v4) = po; }
#pragma unroll
    for (int i = 0; i < 8; ++i) *(f32x4*)(F.out + O_SS + sbase + (size_t)i * 128) = S[i];
    __syncthreads();
    { const int t = tid >> 7, v = tid & 127; float o = 0.f;
#pragma unroll
      for (int q = 0; q < 16; ++q) o += part[(t * 16 + q) * 128 + v];
      const float ss = wave_sum(o * o);
      if (lane == 0) red[F.wave] = ss;
      __syncthreads();
      const float rstd = 1.0f / sqrtf((red[2 * t] + red[2 * t + 1]) * (1.f / 128.f) + EPSN);
      const size_t row = (size_t)MP + b * 4 + t;
      const float y = o * rstd * F.norm_lin[v] * bf2f(F.GTL[row * 512 + h * 128 + v]);
      F.OMIX[row * 1024 + h * 128 + v] = (bf16)f2bf(y); }
    __syncthreads();
}
__device__ __forceinline__ float red16x4(float d0, float d1, float d2, float d3, int lane) {
    const bool o1 = lane & 1, o2 = lane & 2;
    const float s0 = o1 ? d0 : d2, s1 = o1 ? d1 : d3, k0 = o1 ? d2 : d0, k1 = o1 ? d3 : d1;
    const float a0 = k0 + __shfl_xor(s0, 1), a1 = k1 + __shfl_xor(s1, 1);
    const float s = o2 ? a0 : a1, kk = o2 ? a1 : a0;
    float r = kk + __shfl_xor(s, 2);
    r += __shfl_xor(r, 4); r += __shfl_xor(r, 8);
    return r;
}
__device__ __forceinline__ void sat_unit(Frame& F, int unit) {
    const int hg = unit & 1, b = unit >> 1, tid = F.tid, lane = F.lane;
    LAS bf16* P = (LAS bf16*)F.lds;
    LAS float* red = (LAS float*)(F.lds + 65536);
    LAS float* ksum = (LAS float*)(F.lds + 73728);
    LAS float* lpart = (LAS float*)(F.lds + 74752);
    LAS float* gates = (LAS float*)(F.lds + 75264);
    LAS float* lsum = (LAS float*)(F.lds + 75776);
    LAS unsigned* selm = (LAS unsigned*)(F.lds + 76288);
    LAS float* Ltot = (LAS float*)(F.lds + 76352);
    LAS float* pown = (LAS float*)(F.lds + 76416);
    LAS float* racc = (LAS float*)F.lds;
    const int ps = tid >> 6, hl = (tid & 63) >> 4, d4 = tid & 15, hh = 4 * hg + hl;
    float qv[4][4];
#pragma unroll
    for (int q = 0; q < 4; ++q) { const uint2 w = *(const uint2*)(F.QA + ((size_t)MP + b * 4 + q) * 512 + hh * 64 + 4 * d4);
        qv[q][0] = bflo(w.x); qv[q][1] = bfhi(w.x); qv[q][2] = bflo(w.y); qv[q][3] = bfhi(w.y); }
    const int myq = 2 * (lane & 1) + ((lane >> 1) & 1), hqw = hl * 4 + myq;
    const bool writer = d4 < 4;
    const float* tabp = F.TAB + hh * 4096 + PASTLEN + myq;
    for (int j = 0; j < 8; ++j) {
        const int pg0 = F.page_table[b * 16 + 2 * j], pg1 = F.page_table[b * 16 + 2 * j + 1];
        f32x4 ks = {0.f, 0.f, 0.f, 0.f}; float lacc = 0.f;
        for (int it0 = 0; it0 < 32; it0 += 8) {
            f32x4 kk[8];
#pragma unroll
            for (int u = 0; u < 8; ++u) { const int pos = 8 * (it0 + u) + ps; const int pg = pos < 128 ? pg0 : pg1;
                kk[u] = __builtin_nontemporal_load((const f32x4*)(F.cache_k + ((size_t)pg * 128 + (pos & 127)) * 512 + hh * 64 + 4 * d4)); }
#pragma unroll
            for (int u = 0; u < 8; ++u) { const int pos = 8 * (it0 + u) + ps; ks += kk[u];
                float d[4];
#pragma unroll
                for (int q = 0; q < 4; ++q) d[q] = (qv[q][0] * kk[u].x + qv[q][1] * kk[u].y) + (qv[q][2] * kk[u].z + qv[q][3] * kk[u].w);
                const float r = red16x4(d[0], d[1], d[2], d[3], lane);
                if (writer) { const float p = ex2(r + tabp[-(256 * j + pos)]); P[hqw * 2048 + 256 * j + pos] = (bf16)f2bf(p); lacc += p; } }
        }
        *(LAS f32x4*)(red + ps * 256 + hl * 64 + 4 * d4) = ks;
        if (writer) lpart[ps * 16 + hqw] = lacc;
        __syncthreads();
        if (tid < 256) { float s = 0.f;
#pragma unroll
            for (int i = 0; i < 8; ++i) s += red[i * 256 + tid];
            ksum[tid] = s; }
        if (tid >= 256 && tid < 272) { const int hq = tid - 256; float s = 0.f;
#pragma unroll
            for (int i = 0; i < 8; ++i) s += lpart[i * 16 + hq];
            lsum[hq * 8 + j] = s; }
        __syncthreads();
        if (ps == 0) { const f32x4 kq = *(const LAS f32x4*)(ksum + hl * 64 + 4 * d4); float d[4];
#pragma unroll
            for (int q = 0; q < 4; ++q) d[q] = (qv[q][0] * kq.x + qv[q][1] * kq.y) + (qv[q][2] * kq.z + qv[q][3] * kq.w);
            const float r = red16x4(d[0], d[1], d[2], d[3], lane);
            if (writer) gates[hqw * 8 + j] = r; }
    }
    __syncthreads();
    if (tid < 16) { const int hq = tid, q = hq & 3, h2 = 4 * hg + (hq >> 2);
        float g[8];
#pragma unroll
        for (int i = 0; i < 8; ++i) g[i] = gates[hq * 8 + i];
        const unsigned mask = top3mask8(g);
        float Lt = 0.f;
#pragma unroll
        for (int i = 0; i < 8; ++i) if ((mask >> i) & 1u) Lt += lsum[hq * 8 + i];
        const v4u* qp = (const v4u*)(F.QA + ((size_t)MP + b * 4 + q) * 512 + h2 * 64);
        v4u qw[8];
#pragma unroll
        for (int c = 0; c < 8; ++c) qw[c] = qp[c];
#pragma unroll
        for (int i = 0; i < 4; ++i) { float p = 0.f;
            if (i <= q) { const v4u* kp = (const v4u*)(F.KA + ((size_t)MP + b * 4 + i) * 512 + h2 * 64); float s = 0.f;
#pragma unroll
                for (int c = 0; c < 8; ++c) { const v4u kw = kp[c];
                    s += (bflo(qw[c].x) * bflo(kw.x) + bfhi(qw[c].x) * bfhi(kw.x)) + (bflo(qw[c].y) * bflo(kw.y) + bfhi(qw[c].y) * bfhi(kw.y))
                       + (bflo(qw[c].z) * bflo(kw.z) + bfhi(qw[c].z) * bfhi(kw.z)) + (bflo(qw[c].w) * bflo(kw.w) + bfhi(qw[c].w) * bfhi(kw.w)); }
                p = ex2(s + F.TAB[h2 * 4096 + (q - i)]); }
            pown[hq * 4 + i] = p; Lt += p; }
        selm[hq] = mask; Ltot[hq] = Lt; }
    __syncthreads();
    f32x4 acc[4];
#pragma unroll
    for (int q = 0; q < 4; ++q) acc[q] = (f32x4){0.f, 0.f, 0.f, 0.f};
    const unsigned m0 = selm[hl * 4], m1 = selm[hl * 4 + 1], m2 = selm[hl * 4 + 2], m3 = selm[hl * 4 + 3], many = m0 | m1 | m2 | m3;
    for (int j = 0; j < 8; ++j) {
        if ((many >> j) & 1u) {
            const float s0 = (m0 >> j) & 1u ? 1.f : 0.f, s1 = (m1 >> j) & 1u ? 1.f : 0.f, s2 = (m2 >> j) & 1u ? 1.f : 0.f, s3 = (m3 >> j) & 1u ? 1.f : 0.f;
            const int pg0 = F.page_table[b * 16 + 2 * j], pg1 = F.page_table[b * 16 + 2 * j + 1];
            for (int it0 = 0; it0 < 32; it0 += 8) {
                f32x4 vv[8];
#pragma unroll
                for (int u = 0; u < 8; ++u) { const int pos = 8 * (it0 + u) + ps; const int pg = pos < 128 ? pg0 : pg1;
                    vv[u] = __builtin_nontemporal_load((const f32x4*)(F.cache_v + ((size_t)pg * 128 + (pos & 127)) * 512 + hh * 64 + 4 * d4)); }
#pragma unroll
                for (int u = 0; u < 8; ++u) { const int pos = 256 * j + 8 * (it0 + u) + ps; const LAS bf16* pp = P + hl * 4 * 2048 + pos;
                    acc[0] += vv[u] * (bf2f(pp[0]) * s0); acc[1] += vv[u] * (bf2f(pp[2048]) * s1); acc[2] += vv[u] * (bf2f(pp[4096]) * s2); acc[3] += vv[u] * (bf2f(pp[6144]) * s3); }
            }
        }
    }
    if (ps == 0) {
#pragma unroll
        for (int i = 0; i < 4; ++i) { const uint2 w = *(const uint2*)(F.VA + ((size_t)MP + b * 4 + i) * 512 + hh * 64 + 4 * d4);
            const f32x4 vn = {bflo(w.x), bfhi(w.x), bflo(w.y), bfhi(w.y)};
#pragma unroll
            for (int q = 0; q < 4; ++q) acc[q] += vn * pown[(hl * 4 + q) * 4 + i]; }
    }
    __syncthreads();
#pragma unroll
    for (int q = 0; q < 4; ++q) *(LAS f32x4*)(racc + (ps * 16 + hl * 4 + q) * 64 + 4 * d4) = acc[q];
    __syncthreads();
#pragma unroll
    for (int i = 0; i < 2; ++i) { const int idx = tid + 512 * i, hq = idx >> 6, d = idx & 63, q = hq & 3, h2 = 4 * hg + (hq >> 2); float s = 0.f;
#pragma unroll
        for (int p2 = 0; p2 < 8; ++p2) s += racc[(p2 * 16 + hq) * 64 + d];
        const size_t row = (size_t)MP + b * 4 + q;
        const float y = s / Ltot[hq] * bf2f(F.GTA[row * 512 + h2 * 64 + d]);
        F.OMIX[row * 1024 + 512 + h2 * 64 + d] = (bf16)f2bf(y); }
    __syncthreads();
}
__device__ __forceinline__ void sg1_tile(Frame& F, int t, unsigned char* ws) {
    const int rt = t >> 5, ct = t & 31, w = F.wave, wr = w >> 2, wc = w & 3, lane = F.lane, l31 = lane & 31, hi = lane >> 5;
    const bf16* Ap = F.H + (size_t)(MP + 64 * rt + 32 * wr + l31) * DM + 8 * hi;
    const bf16* Bp = F.WIN + (size_t)(128 * ct + 32 * wc + l31) * DM + 8 * hi;
    f32x16 acc = {};
    for (int k0 = 0; k0 < 64; k0 += 8) {
        bf16x8 a[8], bb[8];
#pragma unroll
        for (int u = 0; u < 8; ++u) { a[u] = *(const bf16x8*)(Ap + 16 * (k0 + u)); bb[u] = *(const bf16x8*)(Bp + 16 * (k0 + u)); }
#pragma unroll
        for (int u = 0; u < 8; ++u) acc = __builtin_amdgcn_mfma_f32_32x32x16_bf16(a[u], bb[u], acc, 0, 0, 0);
    }
    const int col = 128 * ct + 32 * wc + l31, type = col >> 9, cin = col & 511;
    size_t bofs = WS_QL;
    switch (type) { case 0: bofs = WS_QL; break; case 2: bofs = WS_VL; break; case 3: bofs = WS_GTL; break; case 4: bofs = WS_QA; break; case 5: bofs = WS_KA; break; case 6: bofs = WS_VA; break; case 7: bofs = WS_GTA; break; default: break; }
    bf16* dstb = (bf16*)(ws + bofs);
    const float lbv = F.LB[cin];
#pragma unroll
    for (int r = 0; r < 16; ++r) { const int srow = 64 * rt + 32 * wr + crow(r, hi); const size_t row = (size_t)MP + srow; float v = acc[r];
        if (type == 0 || type == 3 || type == 7) v = v / (1.0f + __expf(-v));
        else if (type == 1) { const float s = 1.0f / (1.0f + __expf(-v)); v = __logf(lbv + (1.0f - lbv) * s); }
        else if (type == 4) v *= QSCALE;
        if (type == 1) F.GL[row * 512 + cin] = v;
        else dstb[row * 512 + cin] = (bf16)f2bf(v);
        if (type == 5) F.out[O_KS + (size_t)srow * 512 + cin] = v;
        if (type == 6) F.out[O_VS + (size_t)srow * 512 + cin] = v; }
}
__device__ __forceinline__ void hb_scan(Frame& F) {
    const int gt = F.bid * NTHR + F.tid, NGT = F.G * NTHR;
    for (int item = gt; item < 16 * 8192; item += NGT) {
        const int bh = item >> 13, e2 = item & 8191, k = e2 >> 6, v = (e2 & 63) * 2;
        f32x2 S = {0.f, 0.f};
        for (int c0 = 0; c0 < 64; c0 += 8) {
            f32x2 l[8]; float d[8];
#pragma unroll
            for (int u = 0; u < 8; ++u) { const size_t un = (size_t)bh * 64 + c0 + u; l[u] = *(const f32x2*)(F.L + (un * 128 + k) * 128 + v); d[u] = F.DC[un * 128 + k]; }
#pragma unroll
            for (int u = 0; u < 8; ++u) { const size_t un = (size_t)bh * 64 + c0 + u;
                *(unsigned*)(F.SC + (un * 128 + k) * 128 + v) = pg8::cvt_pk_bf16(S.x, S.y);
                S = S * d[u] + l[u]; }
        }
        *(f32x2*)(F.out + O_SP + ((size_t)bh * 128 + k) * 128 + v) = S;
    }
}
__device__ __forceinline__ void hc_unit(Frame& F, int unit) {
    const int c = unit & 63, bh = unit >> 6, h = bh & 3, b = bh >> 2;
    const size_t r0 = (size_t)b * SEQ + c * 64;
    LAS float* tot = (LAS float*)F.lds;
    LAS bf16* Qt = (LAS bf16*)(F.lds + 2048);
    LAS bf16* Qh = (LAS bf16*)(F.lds + 2048 + 17408);
    LAS bf16* Kt = (LAS bf16*)(F.lds + 2048 + 2 * 17408);
    LAS bf16* Vs = (LAS bf16*)(F.lds + 2048 + 3 * 17408);
    LAS bf16* Ss = (LAS bf16*)(F.lds + 2048 + 3 * 17408 + 18432);
    LAS float* Ob = (LAS float*)(F.lds + 2048);
    const int tid = F.tid, lane = F.lane, k = tid & 127, tg = tid >> 7, hi = lane >> 5;
    const float* gp = F.GL + (r0 + tg * 16) * 512 + h * 128 + k;
    const bf16* qp = F.QL + (r0 + tg * 16) * 512 + h * 128 + k;
    float gv[16], cs[16], qv[16]; float run = 0.f;
#pragma unroll
    for (int i = 0; i < 16; ++i) { gv[i] = gp[(size_t)i * 512]; qv[i] = bf2f(qp[(size_t)i * 512]); }
    v4u vreg[2], sreg[4];
#pragma unroll
    for (int i = 0; i < 2; ++i) { const int idx = tid + 512 * i, s = idx >> 4, ch = idx & 15; vreg[i] = *(const v4u*)(F.VL + (r0 + s) * 512 + h * 128 + ch * 8); }
#pragma unroll
    for (int i = 0; i < 4; ++i) { const int idx = tid + 512 * i, kr = idx >> 4, ch = idx & 15; sreg[i] = *(const v4u*)(F.SC + ((size_t)unit * 128 + kr) * 128 + ch * 8); }
#pragma unroll
    for (int i = 0; i < 16; ++i) { run += gv[i]; cs[i] = run; }
    tot[tg * 128 + k] = run;
    __syncthreads();
    const float t0 = tot[k], t1 = tot[128 + k], t2 = tot[256 + k];
    const float prefix = (tg > 0 ? t0 : 0.f) + (tg > 1 ? t1 : 0.f) + (tg > 2 ? t2 : 0.f), rref = t0 + t1;
#pragma unroll
    for (int i = 0; i < 16; ++i) { const float bi = prefix + cs[i], kk = 1.0f - __expf(gv[i]); const int t = tg * 16 + i;
        Qt[t * 136 + k] = (bf16)f2bf(qv[i] * __expf(bi - rref)); Qh[t * 136 + k] = (bf16)f2bf(qv[i] * __expf(bi)); Kt[t * 136 + k] = (bf16)f2bf(kk * __expf(rref - bi)); }
#pragma unroll
    for (int i = 0; i < 2; ++i) { const int idx = tid + 512 * i, s = idx >> 4, ch = idx & 15; *(LAS v4u*)(Vs + s * 144 + ch * 8) = vreg[i]; }
#pragma unroll
    for (int i = 0; i < 4; ++i) { const int idx = tid + 512 * i, kr = idx >> 4, ch = idx & 15; *(LAS v4u*)(Ss + kr * 144 + ch * 8) = sreg[i]; }
    __syncthreads();
    const int w = F.wave, tt = w >> 2, vt = w & 3, g4 = lane >> 4, i16 = lane & 15, l31 = lane & 31;
    f32x16 o = {};
    for (int st = 0; st <= tt; ++st) {
        f32x16 a = {};
#pragma unroll
        for (int kk = 0; kk < 8; ++kk) {
            const bf16x8 A = *(const LAS bf16x8*)(Kt + (32 * st + l31) * 136 + 16 * kk + 8 * hi);
            const bf16x8 B = *(const LAS bf16x8*)(Qt + (32 * tt + l31) * 136 + 16 * kk + 8 * hi);
            a = __builtin_amdgcn_mfma_f32_32x32x16_bf16(A, B, a, 0, 0, 0); }
        if (st == tt) {
#pragma unroll
            for (int r = 0; r < 16; ++r) if (crow(r, hi) > l31) a[r] = 0.f; }
#pragma unroll
        for (int s2 = 0; s2 < 2; ++s2) {
            const bf16x8 pa = pack8(a[8 * s2], a[8 * s2 + 1], a[8 * s2 + 2], a[8 * s2 + 3], a[8 * s2 + 4], a[8 * s2 + 5], a[8 * s2 + 6], a[8 * s2 + 7]);
            const int rowb = 32 * st + 16 * s2 + 4 * (g4 >> 1) + (i16 >> 2), col = 32 * vt + 16 * (g4 & 1) + 4 * (i16 & 3);
            const bf16x8 B = trpair(Vs + rowb * 144 + col, Vs + (rowb + 8) * 144 + col);
            o = __builtin_amdgcn_mfma_f32_32x32x16_bf16(pa, B, o, 0, 0, 0); }
    }
#pragma unroll
    for (int kk = 0; kk < 8; ++kk) {
        const bf16x8 A = *(const LAS bf16x8*)(Qh + (32 * tt + l31) * 136 + 16 * kk + 8 * hi);
        const int rowb = 16 * kk + 8 * (g4 >> 1) + (i16 >> 2), col = 32 * vt + 16 * (g4 & 1) + 4 * (i16 & 3);
        const bf16x8 B = trpair(Ss + rowb * 144 + col, Ss + (rowb + 4) * 144 + col);
        o = __builtin_amdgcn_mfma_f32_32x32x16_bf16(A, B, o, 0, 0, 0); }
    __syncthreads();
#pragma unroll
    for (int r = 0; r < 16; ++r) Ob[(32 * tt + crow(r, hi)) * 132 + 32 * vt + l31] = o[r];
    __syncthreads();
    { const int t = tid >> 3, vc = (tid & 7) * 16; float x[16]; float ss = 0.f;
#pragma unroll
      for (int i = 0; i < 16; i += 4) { const f32x4 q = *(const LAS f32x4*)(Ob + t * 132 + vc + i); x[i] = q.x; x[i + 1] = q.y; x[i + 2] = q.z; x[i + 3] = q.w; ss += (q.x * q.x + q.y * q.y) + (q.z * q.z + q.w * q.w); }
      ss += __shfl_xor(ss, 1); ss += __shfl_xor(ss, 2); ss += __shfl_xor(ss, 4);
      const float rstd = 1.0f / sqrtf(ss * (1.f / 128.f) + EPSN);
      const v4u g0 = *(const v4u*)(F.GTL + (r0 + t) * 512 + h * 128 + vc), g1 = *(const v4u*)(F.GTL + (r0 + t) * 512 + h * 128 + vc + 8);
      const unsigned gw[8] = {g0.x, g0.y, g0.z, g0.w, g1.x, g1.y, g1.z, g1.w};
      unsigned ow[8];
#pragma unroll
      for (int i = 0; i < 8; ++i) { const float a = x[2 * i] * rstd * F.norm_lin[vc + 2 * i] * bflo(gw[i]), bq = x[2 * i + 1] * rstd * F.norm_lin[vc + 2 * i + 1] * bfhi(gw[i]); ow[i] = pg8::cvt_pk_bf16(a, bq); }
      bf16* op = F.OMIX + (r0 + t) * 1024 + h * 128 + vc;
      *(v4u*)op = (v4u){ow[0], ow[1], ow[2], ow[3]}; *(v4u*)(op + 8) = (v4u){ow[4], ow[5], ow[6], ow[7]}; }
    __syncthreads();
}
__device__ __forceinline__ void pa_unit(Frame& F, int b, int h, int o) {
    constexpr int KSZ = 64 * 72;
    LAS bf16* Ks = (LAS bf16*)F.lds;
    LAS bf16* Vs = Ks + 2 * KSZ;
    LAS float* T2 = (LAS float*)(F.lds + 4 * KSZ * 2);
    LAS float* km = T2 + 4096;
    LAS unsigned* sel = (LAS unsigned*)(km + 1024);
    const int tid = F.tid, lane = F.lane, w = F.wave, hi = lane >> 5, l31 = lane & 31, g4 = lane >> 4, i16 = lane & 15;
    const size_t rb = (size_t)b * SEQ;
    for (int i = tid; i < 4096; i += NTHR) T2[i] = F.TAB[h * 4096 + i];
    for (int i = tid; i < 1024; i += NTHR) { const int j = i >> 6, d = i & 63; const float* kp = F.KMP + ((size_t)(b * 64 + 4 * j)) * 512 + h * 64 + d;
        km[i] = (kp[0] + kp[512]) + (kp[1024] + kp[1536]); }
    __syncthreads();
    if (tid < 256) {
        const bf16* qp = F.QA + (rb + 256 * o + tid) * 512 + h * 64;
        float qf[64];
#pragma unroll
        for (int i = 0; i < 8; ++i) { const v4u q = *(const v4u*)(qp + 8 * i); qf[8 * i] = bflo(q.x); qf[8 * i + 1] = bfhi(q.x); qf[8 * i + 2] = bflo(q.y); qf[8 * i + 3] = bfhi(q.y);
            qf[8 * i + 4] = bflo(q.z); qf[8 * i + 5] = bfhi(q.z); qf[8 * i + 6] = bflo(q.w); qf[8 * i + 7] = bfhi(q.w); }
        float b1 = -INFINITY, b2 = -INFINITY, b3 = -INFINITY; int i1 = -1, i2 = -1, i3 = -1;
        for (int j = 0; j < o; ++j) { float g = 0.f;
#pragma unroll
            for (int d = 0; d < 64; d += 4) { const f32x4 kq = *(const LAS f32x4*)(km + j * 64 + d); g += (qf[d] * kq.x + qf[d + 1] * kq.y) + (qf[d + 2] * kq.z + qf[d + 3] * kq.w); }
            if (g > b1) { b3 = b2; i3 = i2; b2 = b1; i2 = i1; b1 = g; i1 = j; } else if (g > b2) { b3 = b2; i3 = i2; b2 = g; i2 = j; } else if (g > b3) { b3 = g; i3 = j; } }
        sel[tid] = (i1 >= 0 ? 1u << i1 : 0u) | (i2 >= 0 ? 1u << i2 : 0u) | (i3 >= 0 ? 1u << i3 : 0u);
    }
    const int qloc = 32 * w + l31; const size_t qrow = rb + 256 * o + qloc;
    bf16x8 qf4[4];
#pragma unroll
    for (int d0 = 0; d0 < 4; ++d0) qf4[d0] = *(const bf16x8*)(F.QA + qrow * 512 + h * 64 + 16 * d0 + 8 * hi);
    const int ntiles = 4 + 4 * o;
    const int skv = tid >> 3, sch = tid & 7;
    v4u kreg, vreg;
    { const int kvb = 256 * o; kreg = *(const v4u*)(F.KA + (rb + kvb + skv) * 512 + h * 64 + sch * 8); vreg = *(const v4u*)(F.VA + (rb + kvb + skv) * 512 + h * 64 + sch * 8); }
    *(LAS v4u*)(Ks + skv * 72 + sch * 8) = kreg; *(LAS v4u*)(Vs + skv * 72 + sch * 8) = vreg;
    __syncthreads();
    const unsigned selm = sel[qloc];
    const int qpos = 256 * o + qloc;
    const float cfar = T2[4095];
    float l = 0.f; f32x16 oa0 = {}, oa1 = {};
    for (int ti = 0; ti < ntiles; ++ti) {
        const int buf = ti & 1;
        if (ti + 1 < ntiles) { const int tn = ti + 1, kvn = tn < 4 ? 256 * o + 64 * tn : 64 * (tn - 4);
            kreg = *(const v4u*)(F.KA + (rb + kvn + skv) * 512 + h * 64 + sch * 8); vreg = *(const v4u*)(F.VA + (rb + kvn + skv) * 512 + h * 64 + sch * 8); }
        const bool own = ti < 4; const int kvb = own ? 256 * o + 64 * ti : 64 * (ti - 4); const int jb = own ? 0 : (ti - 4) >> 2;
        const bool rowsel = own || ((selm >> jb) & 1u);
        const bool active = own ? (ti <= (w >> 1)) : (__any(rowsel) != 0);
        if (active) {
            const LAS bf16* Kb = Ks + buf * KSZ; const LAS bf16* Vb = Vs + buf * KSZ;
            const bool far = (256 * o + 32 * w) - (kvb + 63) >= 800;
            const float cinit = (rowsel ? 0.f : NEGBIG) + (far ? cfar : 0.f);
            f32x16 p0, p1;
#pragma unroll
            for (int r = 0; r < 16; ++r) { p0[r] = cinit; p1[r] = cinit; }
#pragma unroll
            for (int d0 = 0; d0 < 4; ++d0) {
                const bf16x8 a0 = *(const LAS bf16x8*)(Kb + l31 * 72 + 16 * d0 + 8 * hi), a1 = *(const LAS bf16x8*)(Kb + (32 + l31) * 72 + 16 * d0 + 8 * hi);
                p0 = __builtin_amdgcn_mfma_f32_32x32x16_bf16(a0, qf4[d0], p0, 0, 0, 0); p1 = __builtin_amdgcn_mfma_f32_32x32x16_bf16(a1, qf4[d0], p1, 0, 0, 0); }
            const int dbase = qpos - kvb - 4 * hi;
            if (!far) {
                const LAS float* T2p = T2 + (dbase - 59);
#pragma unroll
                for (int r = 0; r < 16; ++r) { const int c = (r & 3) + 8 * (r >> 2); p0[r] += T2p[59 - c]; p1[r] += T2p[27 - c]; }
                if (own) {
#pragma unroll
                    for (int r = 0; r < 16; ++r) { const int c = (r & 3) + 8 * (r >> 2); if (dbase - c < 0) p0[r] = NEGBIG; if (dbase - c - 32 < 0) p1[r] = NEGBIG; }
                }
            }
            float rs = 0.f;
#pragma unroll
            for (int r = 0; r < 16; ++r) { p0[r] = ex2(p0[r]); p1[r] = ex2(p1[r]); rs += p0[r] + p1[r]; }
            l += rs;
            const bf16x8 pb0 = pack8(p0[0], p0[1], p0[2], p0[3], p0[4], p0[5], p0[6], p0[7]), pb1 = pack8(p0[8], p0[9], p0[10], p0[11], p0[12], p0[13], p0[14], p0[15]);
            const bf16x8 pb2 = pack8(p1[0], p1[1], p1[2], p1[3], p1[4], p1[5], p1[6], p1[7]), pb3 = pack8(p1[8], p1[9], p1[10], p1[11], p1[12], p1[13], p1[14], p1[15]);
#define PA_PV(s, PB) do { const int rowb = 16 * (s) + 4 * (g4 >> 1) + (i16 >> 2), col = 16 * (g4 & 1) + 4 * (i16 & 3); \
                const bf16x8 va0 = trpair(Vb + rowb * 72 + col, Vb + (rowb + 8) * 72 + col), va1 = trpair(Vb + rowb * 72 + 32 + col, Vb + (rowb + 8) * 72 + 32 + col); \
                oa0 = __builtin_amdgcn_mfma_f32_32x32x16_bf16(va0, PB, oa0, 0, 0, 0); oa1 = __builtin_amdgcn_mfma_f32_32x32x16_bf16(va1, PB, oa1, 0, 0, 0); } while (0)
            PA_PV(0, pb0); PA_PV(1, pb1); PA_PV(2, pb2); PA_PV(3, pb3);
#undef PA_PV
        }
        if (ti + 1 < ntiles) { *(LAS v4u*)(Ks + (buf ^ 1) * KSZ + skv * 72 + sch * 8) = kreg; *(LAS v4u*)(Vs + (buf ^ 1) * KSZ + skv * 72 + sch * 8) = vreg; }
        __syncthreads();
    }
    l += __shfl_xor(l, 32);
    const float inv = 1.0f / l;
#pragma unroll
    for (int dh = 0; dh < 2; ++dh)
#pragma unroll
        for (int rg = 0; rg < 4; ++rg) { const int d0 = 32 * dh + 8 * rg + 4 * hi;
            const uint2 gw = *(const uint2*)(F.GTA + qrow * 512 + h * 64 + d0);
            const float x0 = (dh ? oa1[4 * rg] : oa0[4 * rg]) * inv * bflo(gw.x), x1 = (dh ? oa1[4 * rg + 1] : oa0[4 * rg + 1]) * inv * bfhi(gw.x);
            const float x2 = (dh ? oa1[4 * rg + 2] : oa0[4 * rg + 2]) * inv * bflo(gw.y), x3 = (dh ? oa1[4 * rg + 3] : oa0[4 * rg + 3]) * inv * bfhi(gw.y);
            uint2 ow; ow.x = pg8::cvt_pk_bf16(x0, x1); ow.y = pg8::cvt_pk_bf16(x2, x3);
            *(uint2*)(F.OMIX + qrow * 1024 + 512 + h * 64 + d0) = ow; }
    __syncthreads();
}
__device__ __forceinline__ void p6_row(Frame& F, int m) {
    const GAS f32x4* orow = (const GAS f32x4*)(F.O2 + (size_t)m * DM) + F.lane; const GAS f32x4* gr = (const GAS f32x4*)F.norm_post + F.lane;
    const GAS f32x4* xr = (const GAS f32x4*)(m < MP ? F.xp + (size_t)m * DM : F.xs + (size_t)(m - MP) * DM) + F.lane;
    GAS f32x4* yr = (GAS f32x4*)(m < MP ? F.out + O_YP + (size_t)m * DM : F.out + O_YS + (size_t)(m - MP) * DM) + F.lane;
    f32x4 v[4]; float s = 0.f;
#pragma unroll
    for (int j = 0; j < 4; ++j) { v[j] = orow[64 * j]; s += (v[j].x * v[j].x + v[j].y * v[j].y) + (v[j].z * v[j].z + v[j].w * v[j].w); }
    const float rstd = 1.0f / sqrtf(wave_sum(s) * (1.f / DM) + EPSN);
#pragma unroll
    for (int j = 0; j < 4; ++j) yr[64 * j] = xr[64 * j] + v[j] * rstd * gr[64 * j];
}

#ifndef MK_PER_PHASE
#define MK_PER_PHASE 0
#endif
constexpr int N_PHASES = 7;
#ifndef REP_PA
#define REP_PA 1
#endif
#ifndef REP_P1
#define REP_P1 1
#endif
#ifndef REP_P2
#define REP_P2 1
#endif
#ifndef REP_P3
#define REP_P3 1
#endif
#ifndef REP_P4
#define REP_P4 1
#endif
struct Args { const void* in[13]; float* out; unsigned char* ws; int ph_lo, ph_hi; };
__global__ void __launch_bounds__(NWAVES * 64, 2) hymba_fwd(Args args) {
    extern __shared__ __attribute__((aligned(16))) unsigned char lds[];
    Frame F;
    F.lds = (LAS unsigned char*)lds;
    F.MISC = (volatile LAS unsigned*)(F.lds + MISC_OFF);
    F.tid = threadIdx.x; F.lane = F.tid & 63; F.wave = __builtin_amdgcn_readfirstlane(F.tid >> 6);
    F.G = gridDim.x; F.bid = blockIdx.x;
    unsigned char* ws = args.ws;
    F.ctl = (gu32*)(ws + WS_CTL);
    F.xp = (const float*)args.in[0]; F.xs = (const float*)args.in[1]; F.cache_k = (const float*)args.in[2]; F.cache_v = (const float*)args.in[3]; F.state = (const float*)args.in[4];
    F.page_table = (const int*)args.in[5]; F.w_in = (const float*)args.in[6]; F.w_out = (const float*)args.in[7]; F.norm_pre = (const float*)args.in[8]; F.norm_post = (const float*)args.in[9];
    F.norm_lin = (const float*)args.in[10]; F.llb = (const float*)args.in[11]; F.rel_bias = (const float*)args.in[12]; F.out = args.out;
    F.WIN = (bf16*)(ws + WS_WIN); F.WOUT = (bf16*)(ws + WS_WOUT); F.H = (bf16*)(ws + WS_H); F.QL = (bf16*)(ws + WS_QL); F.VL = (bf16*)(ws + WS_VL); F.GTL = (bf16*)(ws + WS_GTL);
    F.QA = (bf16*)(ws + WS_QA); F.KA = (bf16*)(ws + WS_KA); F.VA = (bf16*)(ws + WS_VA); F.GTA = (bf16*)(ws + WS_GTA); F.SC = (bf16*)(ws + WS_SC); F.OMIX = (bf16*)(ws + WS_OMIX);
    F.TAB = (float*)(ws + WS_TAB); F.LB = (float*)(ws + WS_LB); F.KMP = (float*)(ws + WS_KMP); F.GATE = (float*)(ws + WS_GATE); F.ML = (float*)(ws + WS_ML); F.DC = (float*)(ws + WS_DC);
    F.GL = (float*)(ws + WS_GL); F.L = (float*)(ws + WS_L); F.LOG = (float*)(ws + WS_LOG); F.OPART = (float*)(ws + WS_OPART); F.O2 = (float*)(ws + WS_O2);
    for (int u = F.tid; u < (LDS_BYTES - LDSCTL_OFF) / 4; u += NWAVES * 64) ((LAS unsigned*)(F.lds + LDSCTL_OFF))[u] = 0u;
    __syncthreads();
    XcdBarrier bar; bar.bar = (unsigned*)(F.ctl + CW_BAR); bar.x = 0; bar.st = nullptr;
    if (!MK_PER_PHASE) bar = xcd_barrier_post((unsigned*)(F.ctl + CW_BAR), F.MISC + 8);
#define GRID_BAR() do { if (!MK_PER_PHASE) xcd_barrier(bar); } while (0)
    const int lo = args.ph_lo, hi = args.ph_hi;
#define IN(k) (lo <= (k) && (k) < hi)
#define BOTH(k) (IN(k) && IN((k) + 1))
    const int bid = F.bid, G = F.G;
    if (IN(0)) { p0_prologue(F); if (BOTH(0)) GRID_BAR(); }
    if (IN(1)) for (int rep = 0; rep < REP_P1; ++rep) {
        for (int t = bid; t < 256; t += G) sg1_tile(F, t, ws);
        pg8::Gemm g{F.H, F.WIN, MP, DIN, DM}; pg8::StaticOrder S; S.init(MP, DIN, G, bid);
        Epi1 E{ws, F.out, F.LB};
        pg8::gemm_phase<Epi1, pg8::StaticOrder, true, true>(F.lds + RING_OFF, g, S, E);
        if (BOTH(1)) GRID_BAR();
    }
    if (IN(2)) for (int rep = 0; rep < REP_P2; ++rep) {
        for (int u = bid; u < 1024; u += G) ha_unit(F, u);
        for (int u = bid; u < 256; u += G) km_unit(F, u);
        for (int u = bid; u < 512; u += G) sh_unit(F, u);
        for (int u = bid; u < 256; u += G) sat_unit(F, u);
        if (BOTH(2)) GRID_BAR();
    }
    if (IN(3)) for (int rep = 0; rep < REP_P3; ++rep) {
        hb_scan(F);
        if (BOTH(3)) GRID_BAR();
    }
    if (IN(4)) for (int rep = 0; rep < REP_P4; ++rep) {
        for (int u = bid; u < 1024; u += G) hc_unit(F, u);
        for (int rp = 0; rp < REP_PA; ++rp) for (int u = bid; u < 256; u += G) { const int bh = u >> 3, s = u & 7; pa_unit(F, bh >> 3, bh & 7, s); pa_unit(F, bh >> 3, bh & 7, 15 - s); }
        if (BOTH(4)) GRID_BAR();
    }
    if (IN(5)) {
        pg8::Gemm g{F.OMIX, F.WOUT, MROWS, DM, DM}; pg8::StaticOrder S; S.init(MROWS, DM, G, bid);
        Epi2 E{F.O2};
        pg8::gemm_phase<Epi2, pg8::StaticOrder, true, true>(F.lds + RING_OFF, g, S, E);
        if (BOTH(5)) GRID_BAR();
    }
    if (IN(6)) { for (int m = bid * NWAVES + F.wave; m < MROWS; m += G * NWAVES) p6_row(F, m); }
#undef IN
#undef BOTH
}

extern "C" void kernel_launch(void* const* d_in, const int* in_sizes, int n_in, void* d_out, int out_size, void* d_ws, size_t ws_size, hipStream_t stream) {
    static int grid = 0;
    if (grid == 0) {
        if (n_in != 13 || (size_t)out_size != O_END || ws_size < WS_END) { fprintf(stderr, "kernel_launch: unexpected shapes (n_in %d out %d ws %zu)\n", n_in, out_size, ws_size); grid = -1; return; }
        int dev = 0, cus = 0, per_cu = 0;
        if (hipGetDevice(&dev) != hipSuccess || hipDeviceGetAttribute(&cus, hipDeviceAttributeMultiprocessorCount, dev) != hipSuccess) { grid = -1; return; }
        if (hipFuncSetAttribute((const void*)hymba_fwd, hipFuncAttributeMaxDynamicSharedMemorySize, LDS_BYTES) != hipSuccess) { fprintf(stderr, "kernel_launch: hipFuncSetAttribute failed\n"); grid = -1; return; }
        if (hipOccupancyMaxActiveBlocksPerMultiprocessor(&per_cu, (const void*)hymba_fwd, NWAVES * 64, LDS_BYTES) != hipSuccess || per_cu < 1) { fprintf(stderr, "kernel_launch: occupancy query says %d\n", per_cu); }
        (void)hipGetLastError();
        grid = cus;
    }
    if (grid < 0) return;
    if (hipMemsetAsync((char*)d_ws + WS_CTL, 0, CTL_ZERO_BYTES, stream) != hipSuccess) return;
    Args a{};
    for (int i = 0; i < 13; ++i) a.in[i] = d_in[i];
    a.out = (float*)d_out; a.ws = (unsigned char*)d_ws;
#if MK_PER_PHASE
    for (int p = 0; p < N_PHASES; ++p) { a.ph_lo = p; a.ph_hi = p + 1; hipLaunchKernelGGL(hymba_fwd, dim3(grid), dim3(NWAVES * 64), LDS_BYTES, stream, a); }
#else
    a.ph_lo = 0; a.ph_hi = N_PHASES;
    hipLaunchKernelGGL(hymba_fwd, dim3(grid), dim3(NWAVES * 64), LDS_BYTES, stream, a);
#endif
}
```

```cpp
#define MK_PER_PHASE 0
#include <hip/hip_runtime.h>
#include <cstdio>
#include <cstdint>
#include <cmath>
namespace pg8 {
#define PG8_LAS __attribute__((address_space(3)))
typedef unsigned short bf16_t;
typedef short bf16x8 __attribute__((ext_vector_type(8)));
typedef float f32x4 __attribute__((ext_vector_type(4)));
typedef unsigned u32x4 __attribute__((ext_vector_type(4)));
constexpr int BM = 256, BK = 64, HALF = 128, HTB = HALF * BK * 2  , STAGE_BYTES = 8 * HTB, NXCD = 8, WGM = 8;

__host__ __device__ __forceinline__ int lds_byte(int r, int c) { const int st = (r >> 4) * 2 + (c >> 5), rr = r & 15, cc = c & 31, ob = rr * 64 + cc * 2; return st * 1024 + (ob ^ (((ob >> 9) & 1) << 5)); }
__host__ __device__ __forceinline__ void stage_rc(int b, int& R, int& C) { const int st = b / 1024, sb = b % 1024, swz = sb ^ (((sb >> 9) & 1) << 5); R = (st >> 1) * 16 + swz / 64; C = (st & 1) * 32 + (swz % 64) / 2; }
__host__ __device__ __forceinline__ int perm32(int rho) { const int n = rho >> 4, i = rho & 15; return 8 * (i >> 2) + 4 * n + (i & 3); }

struct Unit { int pm, pn; };
struct Gemm { const bf16_t* A; const bf16_t* Bt; int M, N, K; };

struct StaticOrder {
    int nM, nN, nwg, G, c;
    __host__ __device__ void init(int M, int N, int G_, int c_) { nM = M / BM; nN = N / BM; nwg = nM * nN; G = G_; c = c_; }
    __host__ __device__ bool next(int i, Unit& u) const {
        const long L = (long)i * G + c; if (L >= nwg) return false;
        int wgid = (int)L; { const int q = nwg / NXCD, r = nwg % NXCD, xcd = wgid % NXCD, off = wgid / NXCD; wgid = (xcd < r ? xcd * (q + 1) : r * (q + 1) + (xcd - r) * q) + off; }
        const int nig = WGM * nN, gid = wgid / nig, fm = gid * WGM, gsz = (nM - fm) < WGM ? (nM - fm) : WGM;
        u.pm = fm + ((wgid % nig) % gsz); u.pn = (wgid % nig) / gsz; return true;
    }
    __device__ __forceinline__ void a_ready(const Unit&) const {}
    __device__ __forceinline__ void done(const Unit&) const {}
};

__device__ __forceinline__ unsigned cvt_pk_bf16(float lo, float hi) { unsigned r; asm volatile("v_cvt_pk_bf16_f32 %0, %1, %2" : "=v"(r) : "v"(lo), "v"(hi)); return r; }
typedef float f32x2 __attribute__((ext_vector_type(2)));
template <class Epi, class Sched, bool ALIGN_EPI = false, bool SP2 = false>
__device__ __forceinline__ void gemm_phase(PG8_LAS unsigned char* lds, const Gemm g, const Sched& S, const Epi& E) {
    const int tid = threadIdx.x, wid = __builtin_amdgcn_readfirstlane(tid >> 6), lane = tid & 63, wr = wid >> 2, wc = wid & 3, fr = lane & 15, fq = lane >> 4;
    const int K = g.K, nt = K / BK;
    unsigned voffA[2], voffB[2];
#pragma unroll
    for (int i = 0; i < 2; ++i) { int R, C; stage_rc(tid * 16 + i * 8192, R, C); const int Rb = Epi::PERM ? ((R & ~31) + perm32(R & 31)) : R;
        voffA[i] = (unsigned)(R * K + C) * 2u; voffB[i] = (unsigned)(Rb * K + C) * 2u; }
    const size_t kstep = (size_t)(BK * 2);
    const size_t hstep = (size_t)HALF * K * 2;
    const size_t tstep = 2 * hstep;
    const unsigned ldsw = (unsigned)wid * 1024u;
    const int aoff = lds_byte(wr * 64 + fr, fq * 8), boff = lds_byte(wc * 32 + fr, fq * 8);
#define PG8_SA(b, h) (((b) * 2 + (h)) * HTB)
#define PG8_SB(b, h) ((4 + (b) * 2 + (h)) * HTB)
#define PG8_STAGE(bufoff, gbase, voff) do { _Pragma("unroll") for (int _i = 0; _i < 2; ++_i) \
        __builtin_amdgcn_global_load_lds((const unsigned*)((const char*)(gbase) + (voff)[_i]), (PG8_LAS unsigned*)(lds + (bufoff) + ldsw + _i * 8192), 16, 0, 0); } while (0)
#define PG8_LDA(dst, b, h) do { _Pragma("unroll") for (int m = 0; m < 4; ++m) _Pragma("unroll") for (int k = 0; k < 2; ++k) dst[m][k] = *(const PG8_LAS bf16x8*)(lds + PG8_SA(b, h) + aoff + m * 2048 + k * 1024); } while (0)
#define PG8_LDB(dst, b, h) do { _Pragma("unroll") for (int n = 0; n < 2; ++n) _Pragma("unroll") for (int k = 0; k < 2; ++k) dst[n][k] = *(const PG8_LAS bf16x8*)(lds + PG8_SB(b, h) + boff + n * 2048 + k * 1024); } while (0)
#define PG8_MMA(ai, bj, At, Bt) do { __builtin_amdgcn_s_setprio(1); _Pragma("unroll") for (int m = 0; m < 4; ++m) _Pragma("unroll") for (int n = 0; n < 2; ++n) _Pragma("unroll") for (int k = 0; k < 2; ++k) \
        acc[ai][bj][m][n] = __builtin_amdgcn_mfma_f32_16x16x32_bf16(Bt[n][k], At[m][k], acc[ai][bj][m][n], 0, 0, 0); __builtin_amdgcn_s_setprio(0); } while (0)
#define PG8_WAIT_V(n) asm volatile("s_waitcnt vmcnt(" #n ")" ::: "memory")
#define PG8_WAIT_L(n) asm volatile("s_waitcnt lgkmcnt(" #n ")" ::: "memory")
#define PG8_BAR __builtin_amdgcn_s_barrier()
#define PG8_SCHED __builtin_amdgcn_sched_barrier(0)
    Unit cur, nxt; int ui = 0;
    if (!S.next(0, cur)) return;
    f32x4 acc[2][2][4][2];
#pragma unroll
    for (int a = 0; a < 2; ++a)
#pragma unroll
        for (int b = 0; b < 2; ++b)
#pragma unroll
            for (int m = 0; m < 4; ++m)
#pragma unroll
                for (int n = 0; n < 2; ++n) acc[a][b][m][n] = (f32x4){0.f, 0.f, 0.f, 0.f};
    bf16x8 At[4][2], B0[2][2], B1[2][2];
    const char* cA = (const char*)g.A + (size_t)cur.pm * tstep; const char* cB = (const char*)g.Bt + (size_t)cur.pn * tstep;
    S.a_ready(cur);
    if constexpr (SP2) {
        PG8_STAGE(PG8_SB(0, 0), cB, voffB); PG8_STAGE(PG8_SB(0, 1), cB + hstep, voffB); PG8_STAGE(PG8_SA(0, 0), cA, voffA); PG8_STAGE(PG8_SA(0, 1), cA + hstep, voffA);
        if (wr == 1) PG8_BAR;
        PG8_WAIT_V(2); PG8_BAR;
        PG8_STAGE(PG8_SB(1, 0), cB + kstep, voffB); PG8_STAGE(PG8_SA(1, 0), cA + kstep, voffA); PG8_STAGE(PG8_SB(1, 1), cB + hstep + kstep, voffB);
        PG8_WAIT_V(6); PG8_BAR;
    } else {
        PG8_STAGE(PG8_SB(0, 0), cB, voffB); PG8_STAGE(PG8_SA(0, 0), cA, voffA); PG8_STAGE(PG8_SB(0, 1), cB + hstep, voffB); PG8_STAGE(PG8_SA(0, 1), cA + hstep, voffA);
        if (wr == 1) PG8_BAR;
        PG8_WAIT_V(4); PG8_BAR;
        PG8_STAGE(PG8_SB(1, 0), cB + kstep, voffB); PG8_STAGE(PG8_SA(1, 0), cA + kstep, voffA); PG8_STAGE(PG8_SB(1, 1), cB + hstep + kstep, voffB);
        PG8_WAIT_V(6); PG8_BAR;
    }
    for (;;) {
        const bool has_next = S.next(ui + 1, nxt);
        const char* nA = has_next ? (const char*)g.A + (size_t)nxt.pm * tstep : cA; const char* nB = has_next ? (const char*)g.Bt + (size_t)nxt.pn * tstep : cB;
        for (int t = 0; t < nt; t += 2) {
            const bool last = (t == nt - 2);
            const char* a1 = cA + (size_t)(t + 1) * kstep;
            const char* a2 = last ? nA : cA + (size_t)(t + 2) * kstep; const char* b2 = last ? nB : cB + (size_t)(t + 2) * kstep;
            const char* a3 = a2 + kstep; const char* b3 = b2 + kstep;
            if (last && has_next) S.a_ready(nxt);
            if constexpr (SP2) {
            PG8_LDB(B0, 0, 0); PG8_LDB(B1, 0, 1); PG8_SCHED; PG8_LDA(At, 0, 0); PG8_STAGE(PG8_SA(1, 1), a1 + hstep, voffA);
            PG8_WAIT_V(8); PG8_WAIT_L(0); PG8_BAR; PG8_MMA(0, 0, At, B0); PG8_MMA(0, 1, At, B1); PG8_BAR; PG8_SCHED;
            PG8_LDA(At, 0, 1); PG8_STAGE(PG8_SB(0, 0), b2, voffB); PG8_STAGE(PG8_SB(0, 1), b2 + hstep, voffB); PG8_STAGE(PG8_SA(0, 0), a2, voffA);
            PG8_WAIT_V(8); PG8_WAIT_L(0); PG8_BAR; PG8_MMA(1, 0, At, B0); PG8_MMA(1, 1, At, B1); PG8_BAR; PG8_SCHED;
            PG8_LDB(B0, 1, 0); PG8_LDB(B1, 1, 1); PG8_SCHED; PG8_LDA(At, 1, 0); PG8_STAGE(PG8_SA(0, 1), a2 + hstep, voffA);
            PG8_WAIT_V(8); PG8_WAIT_L(0); PG8_BAR; PG8_MMA(0, 0, At, B0); PG8_MMA(0, 1, At, B1); PG8_BAR; PG8_SCHED;
            PG8_LDA(At, 1, 1); PG8_STAGE(PG8_SB(1, 0), b3, voffB); PG8_STAGE(PG8_SB(1, 1), b3 + hstep, voffB); PG8_STAGE(PG8_SA(1, 0), a3, voffA);
            PG8_WAIT_V(8); PG8_WAIT_L(0); PG8_BAR; PG8_MMA(1, 0, At, B0); PG8_MMA(1, 1, At, B1); PG8_BAR; PG8_SCHED;
            } else {
            PG8_LDB(B0, 0, 0); PG8_SCHED; PG8_LDA(At, 0, 0); PG8_STAGE(PG8_SA(1, 1), a1 + hstep, voffA);
            PG8_WAIT_L(8); PG8_BAR; PG8_WAIT_L(0); PG8_MMA(0, 0, At, B0); PG8_BAR; PG8_SCHED;
            PG8_LDB(B1, 0, 1); PG8_STAGE(PG8_SB(0, 0), b2, voffB);
            PG8_BAR; PG8_WAIT_L(0); PG8_MMA(0, 1, At, B1); PG8_BAR;
            PG8_LDA(At, 0, 1); PG8_STAGE(PG8_SA(0, 0), a2, voffA);
            PG8_BAR; PG8_WAIT_L(0); PG8_MMA(1, 0, At, B0); PG8_BAR; PG8_SCHED;
            PG8_STAGE(PG8_SB(0, 1), b2 + hstep, voffB);
            PG8_WAIT_V(6); PG8_BAR; PG8_MMA(1, 1, At, B1); PG8_BAR;
            PG8_LDB(B0, 1, 0); PG8_SCHED; PG8_LDA(At, 1, 0); PG8_STAGE(PG8_SA(0, 1), a2 + hstep, voffA);
            PG8_WAIT_L(8); PG8_BAR; PG8_WAIT_L(0); PG8_MMA(0, 0, At, B0); PG8_BAR; PG8_SCHED;
            PG8_LDB(B1, 1, 1); PG8_STAGE(PG8_SB(1, 0), b3, voffB);
            PG8_BAR; PG8_WAIT_L(0); PG8_MMA(0, 1, At, B1); PG8_BAR;
            PG8_LDA(At, 1, 1); PG8_STAGE(PG8_SA(1, 0), a3, voffA);
            PG8_BAR; PG8_WAIT_L(0); PG8_MMA(1, 0, At, B0); PG8_BAR; PG8_SCHED;
            PG8_STAGE(PG8_SB(1, 1), b3 + hstep, voffB);
            PG8_WAIT_V(6); PG8_BAR; PG8_MMA(1, 1, At, B1); PG8_BAR;
            }
        }
        if constexpr (ALIGN_EPI) { if (wr == 0) PG8_BAR; }
        if constexpr (!Epi::AFTER_DRAIN) { E(acc, cur, wr, wc, fr, fq); S.done(cur); }
        if (!has_next) break;
#pragma unroll
        for (int a = 0; a < 2; ++a)
#pragma unroll
            for (int b = 0; b < 2; ++b)
#pragma unroll
                for (int m = 0; m < 4; ++m)
#pragma unroll
                    for (int n = 0; n < 2; ++n) acc[a][b][m][n] = (f32x4){0.f, 0.f, 0.f, 0.f};
        cur = nxt; cA = nA; cB = nB; ++ui;
        if constexpr (ALIGN_EPI) { if (wr == 1) PG8_BAR; }
    }
    PG8_WAIT_V(0);
    if constexpr (!ALIGN_EPI) { if (wr == 0) PG8_BAR; }
    PG8_BAR;
    if constexpr (Epi::AFTER_DRAIN) { E.fused(acc, cur, wr, wc, fr, fq, lds, wid, lane); S.done(cur); }
#undef PG8_SA
#undef PG8_SB
#undef PG8_STAGE
#undef PG8_LDA
#undef PG8_LDB
#undef PG8_MMA
#undef PG8_WAIT_V
#undef PG8_WAIT_L
#undef PG8_BAR
#undef PG8_SCHED
}
}

constexpr int NWAVES = 8, NTHR = 512;
constexpr int DM = 1024, SEQ = 4096, NBATCH = 4, MP = NBATCH * SEQ, DECB = 128, DECS = 4, MS = DECB * DECS, MROWS = MP + MS;
constexpr int DIN = 4096, DL = 512;
constexpr float EPSN = 1e-6f;
constexpr float LOG2E = 1.4426950408889634f;
constexpr float QSCALE = 0.125f * LOG2E;
constexpr float NEGBIG = -1.0e30f;
constexpr int PASTLEN = 2048;
constexpr size_t O_YP = 0, O_YS = O_YP + (size_t)MP * DM, O_KP = O_YS + (size_t)MS * DM, O_VP = O_KP + (size_t)MP * 512, O_SP = O_VP + (size_t)MP * 512,
                 O_KS = O_SP + (size_t)16 * 16384, O_VS = O_KS + (size_t)MS * 512, O_SS = O_VS + (size_t)MS * 512, O_END = O_SS + (size_t)512 * 16384;
constexpr size_t MiB = 1u << 20;
constexpr size_t WS_CTL = 0, CTL_ZERO_BYTES = 1 * MiB;
constexpr size_t WS_WIN = 2 * MiB, WS_WOUT = 10 * MiB, WS_TAB = 12 * MiB, WS_LB = 12 * MiB + 256 * 1024, WS_KMP = 13 * MiB, WS_GATE = 13 * MiB + 512 * 1024,
                 WS_ML = 14 * MiB, WS_DC = 15 * MiB, WS_H = 16 * MiB, WS_QL = 50 * MiB, WS_VL = 67 * MiB, WS_GTL = 84 * MiB, WS_QA = 101 * MiB, WS_KA = 118 * MiB,
                 WS_VA = 135 * MiB, WS_GTA = 152 * MiB, WS_GL = 170 * MiB, WS_L = 204 * MiB, WS_SC = 268 * MiB, WS_LOG = 300 * MiB, WS_OPART = 332 * MiB,
                 WS_OMIX = 340 * MiB, WS_O2 = 374 * MiB, WS_END = 440 * MiB;
constexpr int CW_BAR = 4096;
constexpr int RING_OFF = 0, RING_BYTES = 131072;
constexpr int LDSCTL_OFF = RING_BYTES, MISC_OFF = LDSCTL_OFF + 320;
constexpr int LDS_BYTES = 147456;

#define GAS __attribute__((address_space(1)))
#define LAS __attribute__((address_space(3)))
typedef unsigned short bf16;
typedef unsigned v4u __attribute__((ext_vector_type(4)));
typedef float f32x4 __attribute__((ext_vector_type(4)));
typedef short bf16x8 __attribute__((ext_vector_type(8)));
typedef GAS unsigned gu32;
typedef GAS unsigned long long gu64;
#define RLX_AGENT __ATOMIC_RELAXED, __HIP_MEMORY_SCOPE_AGENT
#define LDS_WAIT() asm volatile("s_waitcnt lgkmcnt(0)" ::: "memory")
#define VM_WAIT() asm volatile("s_waitcnt vmcnt(0)" ::: "memory")
__device__ __forceinline__ unsigned long long rt() { return __builtin_amdgcn_s_memrealtime(); }
__device__ __forceinline__ unsigned f2bf(float f) { unsigned u = __builtin_bit_cast(unsigned, f); return (u + 0x7fffu + ((u >> 16) & 1u)) >> 16; }
__device__ __forceinline__ unsigned pk2(float lo, float hi) { return f2bf(lo) | (f2bf(hi) << 16); }

#define XB_TMO      128
#define XB_XCNT(j)  (256  + 64 * (j))
#define XB_XSUB(j)  (1280 + 64 * (j))
#define XB_XGEN(j)  (2304 + 64 * (j))
#define XB_TOP      3328
#define XB_TOPGEN   3392
#define XCD_BAR_WORDS 3456
#define XB_SPIN_CAP (1u << 18)

__device__ __forceinline__ unsigned xb_ld(unsigned* p)              { return __hip_atomic_load(p, __ATOMIC_RELAXED, __HIP_MEMORY_SCOPE_AGENT); }
__device__ __forceinline__ unsigned xb_add(unsigned* p, unsigned v) { return __hip_atomic_fetch_add(p, v, __ATOMIC_RELAXED, __HIP_MEMORY_SCOPE_AGENT); }
__device__ __forceinline__ unsigned xb_xcc_id() { return (unsigned)__builtin_amdgcn_s_getreg((3 << 11) | 20) & 0xFu; }
#define XB_SPIN(cond, bar) do { unsigned _sp = 0; while (cond) { __builtin_amdgcn_s_sleep(1); \
    if ((++_sp & 255u) == 0u) { if (xb_ld(&(bar)[XB_TMO])) break; if (_sp > XB_SPIN_CAP) { atomicAdd(&(bar)[XB_TMO], 1u); break; } } } } while (0)

struct XcdBarrier {
    unsigned* bar; unsigned x;
    volatile LAS unsigned* st;
};

__device__ __forceinline__ XcdBarrier xcd_barrier_post(unsigned* bar, volatile LAS unsigned* st) {
    XcdBarrier b; b.bar = bar; b.x = xb_xcc_id(); b.st = st;
    if (threadIdx.x == 0) (void)xb_add(&bar[XB_XCNT(b.x)], 1u);
    return b;
}
__device__ __forceinline__ void xcd_barrier_complete(unsigned* bar, unsigned x, unsigned& nloc, unsigned& nx) {
    const unsigned G = gridDim.x * gridDim.y * gridDim.z;
    unsigned sum, cnt, mine, sp = 0u;
    for (;;) {
        sum = 0u; cnt = 0u; mine = 0u;
#pragma unroll
        for (unsigned j = 0; j < 16; ++j) { const unsigned c = xb_ld(&bar[XB_XCNT(j)]); sum += c; cnt += (c > 0u) ? 1u : 0u; mine = (j == x) ? c : mine; }
        if (sum == G) break;
        __builtin_amdgcn_s_sleep(1);
        if ((++sp & 255u) == 0u) { if (xb_ld(&bar[XB_TMO])) break; if (sp > XB_SPIN_CAP) { atomicAdd(&bar[XB_TMO], 1u); break; } }
    }
    nloc = mine > 0u ? mine : 1u; nx = cnt > 0u ? cnt : 1u;
}

__device__ __forceinline__ void xcd_barrier(const XcdBarrier& b) {
    asm volatile("s_waitcnt vmcnt(0)" ::: "memory");
    __syncthreads();
    if (threadIdx.x == 0) {
        unsigned* bar = b.bar;
        __builtin_amdgcn_s_waitcnt(0);
        unsigned nloc = b.st[0], nx = b.st[1];
        if (nloc == 0u) { xcd_barrier_complete(bar, b.x, nloc, nx); b.st[0] = nloc; b.st[1] = nx; }
        const unsigned old = xb_add(&bar[XB_XSUB(b.x)], 1u);
        const unsigned gen = old / nloc;
        if (old + 1u == (gen + 1u) * nloc) {
            __builtin_amdgcn_fence(__ATOMIC_RELEASE, "agent");
            asm volatile("s_waitcnt vmcnt(0)" ::: "memory");
            const unsigned og = xb_add(&bar[XB_TOP], 1u);
            const unsigned tg = og / nx;
            if (og + 1u == (tg + 1u) * nx) xb_add(&bar[XB_TOPGEN], 1u);
            else XB_SPIN(xb_ld(&bar[XB_TOPGEN]) == tg, bar);
            __builtin_amdgcn_fence(__ATOMIC_ACQUIRE, "agent");
            xb_add(&bar[XB_XGEN(b.x)], 1u);
            asm volatile("s_waitcnt vmcnt(0)" ::: "memory");
        } else {
            XB_SPIN(xb_ld(&bar[XB_XGEN(b.x)]) == gen, bar);
            __builtin_amdgcn_fence(__ATOMIC_ACQUIRE, "agent");
            asm volatile("s_waitcnt vmcnt(0)" ::: "memory");
        }
    }
    __syncthreads();
}
__device__ __forceinline__ void p0_transpose_item(const float* W, int K, int N, bf16* WT, int row_off, LAS float* scr, int item, int lane) {
    const int nblk = N / 32, kb = item / nblk, nb = item % nblk, k0 = 64 * kb, n0 = 32 * nb;
#pragma unroll 8
    for (int i = 0; i < 32; ++i) { const int kk = 2 * i + (lane >> 5); scr[kk * 33 + (lane & 31)] = W[(size_t)(k0 + kk) * N + n0 + (lane & 31)]; }
    LDS_WAIT(); asm volatile("" ::: "memory");
    const int c = lane & 7;
#pragma unroll
    for (int j = 0; j < 4; ++j) { const int n = (lane >> 3) + 8 * j; const LAS float* s = scr + (8 * c) * 33 + n;
        v4u o; o.x = pk2(s[0 * 33], s[1 * 33]); o.y = pk2(s[2 * 33], s[3 * 33]); o.z = pk2(s[4 * 33], s[5 * 33]); o.w = pk2(s[6 * 33], s[7 * 33]);
        *(GAS v4u*)(WT + (size_t)(row_off + n0 + n) * K + k0 + 8 * c) = o; }
    LDS_WAIT(); asm volatile("" ::: "memory");
}

typedef short v4i16_t __attribute__((ext_vector_type(4)));
typedef float f32x16 __attribute__((ext_vector_type(16)));
typedef float f32x2 __attribute__((ext_vector_type(2)));
struct Frame {
    LAS unsigned char* lds;
    volatile LAS unsigned* MISC;
    gu32* ctl;
    int tid, lane, wave, G, bid;
    const float *xp, *xs, *cache_k, *cache_v, *state, *w_in, *w_out, *norm_pre, *norm_post, *norm_lin, *llb, *rel_bias;
    const int* page_table;
    float* out;
    bf16 *WIN, *WOUT, *H, *QL, *VL, *GTL, *QA, *KA, *VA, *GTA, *SC, *OMIX;
    float *TAB, *LB, *KMP, *GATE, *ML, *DC, *GL, *L, *LOG, *OPART, *O2;
};
__device__ __forceinline__ float bf2f(bf16 b) { return __uint_as_float((unsigned)b << 16); }
__device__ __forceinline__ float bflo(unsigned w) { return __uint_as_float(w << 16); }
__device__ __forceinline__ float bfhi(unsigned w) { return __uint_as_float(w & 0xffff0000u); }
__device__ __forceinline__ float ex2(float x) { return __builtin_amdgcn_exp2f(x); }
__device__ __forceinline__ float wave_sum(float v) {
#pragma unroll
    for (int o = 1; o < 64; o <<= 1) v += __shfl_xor(v, o);
    return v;
}
__device__ __forceinline__ float wave_max(float v) {
#pragma unroll
    for (int o = 1; o < 64; o <<= 1) v = fmaxf(v, __shfl_xor(v, o));
    return v;
}
__device__ __forceinline__ int crow(int r, int hi) { return (r & 3) + 8 * (r >> 2) + 4 * hi; }
__device__ __forceinline__ bf16x8 trpair(const LAS bf16* p0, const LAS bf16* p1) {
    const v4i16_t a = __builtin_amdgcn_ds_read_tr16_b64_v4i16((LAS v4i16_t*)p0);
    const v4i16_t b = __builtin_amdgcn_ds_read_tr16_b64_v4i16((LAS v4i16_t*)p1);
    return (bf16x8){a[0], a[1], a[2], a[3], b[0], b[1], b[2], b[3]};
}
__device__ __forceinline__ bf16x8 pack8(float a0, float a1, float a2, float a3, float a4, float a5, float a6, float a7) {
    v4u w; w.x = pg8::cvt_pk_bf16(a0, a1); w.y = pg8::cvt_pk_bf16(a2, a3); w.z = pg8::cvt_pk_bf16(a4, a5); w.w = pg8::cvt_pk_bf16(a6, a7);
    return __builtin_bit_cast(bf16x8, w);
}
__device__ __forceinline__ unsigned top3mask8(const float (&g)[8]) {
    unsigned mask = 0;
#pragma unroll
    for (int n = 0; n < 3; ++n) { float bv = -INFINITY; int bi = 0;
#pragma unroll
        for (int j = 0; j < 8; ++j) { const bool free = !((mask >> j) & 1u); if (free && g[j] > bv) { bv = g[j]; bi = j; } }
        mask |= 1u << bi; }
    return mask;
}

__device__ __forceinline__ void rms_row_to_bf16(const float* xrow, const float* g, bf16* orow, int lane) {
    const GAS f32x4* xr = (const GAS f32x4*)xrow + lane; const GAS f32x4* gr = (const GAS f32x4*)g + lane;
    f32x4 v[4]; float s = 0.f;
#pragma unroll
    for (int j = 0; j < 4; ++j) { v[j] = xr[64 * j]; s += (v[j].x * v[j].x + v[j].y * v[j].y) + (v[j].z * v[j].z + v[j].w * v[j].w); }
    const float rstd = 1.0f / sqrtf(wave_sum(s) * (1.f / DM) + EPSN);
    GAS unsigned long long* o8 = (GAS unsigned long long*)orow + lane;
#pragma unroll
    for (int j = 0; j < 4; ++j) { const f32x4 gv = gr[64 * j];
        o8[64 * j] = (unsigned long long)pk2(v[j].x * rstd * gv.x, v[j].y * rstd * gv.y) | ((unsigned long long)pk2(v[j].z * rstd * gv.z, v[j].w * rstd * gv.w) << 32); }
}
__device__ __forceinline__ void p0_prologue(Frame& F) {
    LAS float* scr = (LAS float*)(F.lds + RING_OFF + F.wave * 16384);
    const int gw = F.bid * NWAVES + F.wave, NGW = F.G * NWAVES;
    constexpr int I_IN = (DM / 64) * (DIN / 32), I_OUT = (DM / 64) * (DM / 32);
    for (int it = gw; it < I_IN + I_OUT; it += NGW) {
        if (it < I_IN) p0_transpose_item(F.w_in, DM, DIN, F.WIN, 0, scr, it, F.lane);
        else p0_transpose_item(F.w_out, DM, DM, F.WOUT, 0, scr, it - I_IN, F.lane);
    }
    for (int m = gw; m < MROWS; m += NGW) {
        const float* xrow = m < MP ? F.xp + (size_t)m * DM : F.xs + (size_t)(m - MP) * DM;
        rms_row_to_bf16(xrow, F.norm_pre, F.H + (size_t)m * DM, F.lane);
    }
    const int gt = F.bid * NTHR + F.tid, NGT = F.G * NTHR;
    for (int i = gt; i < DL; i += NGT) F.LB[i] = 1.0f / (1.0f + expf(F.llb[DL + i] - F.llb[i]));
    for (int i = gt; i < 8 * 4096; i += NGT) { const int h = i >> 12, d = i & 4095; int bk;
        if (d < 16) bk = d; else { const float lg = logf((float)d / 16.0f) / 4.1588830833596715f * 16.0f; int q = 16 + (int)lg; bk = q < 31 ? q : 31; }
        F.TAB[i] = F.rel_bias[bk * 8 + h] * LOG2E; }
}

struct Epi1 {
    static constexpr bool PERM = true, AFTER_DRAIN = false;
    unsigned char* ws; float* out; const float* lb;
    __device__ __forceinline__ void operator()(const pg8::f32x4 (&acc)[2][2][4][2], const pg8::Unit& u, int wr, int wc, int fr, int fq) const {
        const int type = u.pn >> 1;
        const int cg0 = (u.pn & 1) * 256 + wc * 32 + 8 * fq;
        const int row0 = u.pm * 256 + wr * 64 + fr;
        size_t bofs = WS_QL;
        switch (type) { case 0: bofs = WS_QL; break; case 2: bofs = WS_VL; break; case 3: bofs = WS_GTL; break; case 4: bofs = WS_QA; break; case 5: bofs = WS_KA; break; case 6: bofs = WS_VA; break; case 7: bofs = WS_GTA; break; default: break; }
        bf16* dstb = (bf16*)(ws + bofs);
        float* dstf = nullptr;
        if (type == 1) dstf = (float*)(ws + WS_GL);
        if (type == 5) dstf = (u.pm < 64) ? out + O_KP : out + O_KS - (size_t)MP * 512;
        if (type == 6) dstf = (u.pm < 64) ? out + O_VP : out + O_VS - (size_t)MP * 512;
        float lbv[2][8];
#pragma unroll
        for (int bj = 0; bj < 2; ++bj)
#pragma unroll
            for (int i = 0; i < 8; ++i) lbv[bj][i] = (type == 1) ? lb[cg0 + bj * 128 + i] : 0.f;
#pragma unroll
        for (int ai = 0; ai < 2; ++ai)
#pragma unroll
            for (int m = 0; m < 4; ++m) { const size_t row = (size_t)(row0 + ai * 128 + m * 16);
#pragma unroll
                for (int bj = 0; bj < 2; ++bj) { const int col = cg0 + bj * 128;
                    float v[8];
#pragma unroll
                    for (int i = 0; i < 4; ++i) { v[i] = acc[ai][bj][m][0][i]; v[4 + i] = acc[ai][bj][m][1][i]; }
                    if (type == 0 || type == 3 || type == 7) {
#pragma unroll
                        for (int i = 0; i < 8; ++i) v[i] = v[i] / (1.0f + __expf(-v[i]));
                    } else if (type == 1) {
#pragma unroll
                        for (int i = 0; i < 8; ++i) { const float s = 1.0f / (1.0f + __expf(-v[i])); v[i] = __logf(lbv[bj][i] + (1.0f - lbv[bj][i]) * s); }
                    } else if (type == 4) {
#pragma unroll
                        for (int i = 0; i < 8; ++i) v[i] *= QSCALE;
                    }
                    if (type == 1 || type == 5 || type == 6) { float* p = dstf + row * 512 + col;
                        *(pg8::f32x4*)p = (pg8::f32x4){v[0], v[1], v[2], v[3]}; *(pg8::f32x4*)(p + 4) = (pg8::f32x4){v[4], v[5], v[6], v[7]}; }
                    if (type != 1) { pg8::u32x4 w; w.x = pg8::cvt_pk_bf16(v[0], v[1]); w.y = pg8::cvt_pk_bf16(v[2], v[3]); w.z = pg8::cvt_pk_bf16(v[4], v[5]); w.w = pg8::cvt_pk_bf16(v[6], v[7]);
                        *(pg8::u32x4*)(dstb + row * 512 + col) = w; }
                } }
    }
};
struct Epi2 {
    static constexpr bool PERM = false, AFTER_DRAIN = false;
    float* O2;
    __device__ __forceinline__ void operator()(const pg8::f32x4 (&acc)[2][2][4][2], const pg8::Unit& u, int wr, int wc, int fr, int fq) const {
        const int row0 = u.pm * 256 + wr * 64 + fr, col0 = u.pn * 256 + wc * 32 + 4 * fq;
#pragma unroll
        for (int ai = 0; ai < 2; ++ai)
#pragma unroll
            for (int m = 0; m < 4; ++m) { float* rp = O2 + (size_t)(row0 + ai * 128 + m * 16) * DM + col0;
#pragma unroll
                for (int bj = 0; bj < 2; ++bj)
#pragma unroll
                    for (int n = 0; n < 2; ++n) *(pg8::f32x4*)(rp + bj * 128 + n * 16) = acc[ai][bj][m][n]; }
    }
};

__device__ __forceinline__ void ha_unit(Frame& F, int unit) {
    const int c = unit & 63, bh = unit >> 6, h = bh & 3, b = bh >> 2;
    const size_t r0 = (size_t)b * SEQ + c * 64;
    LAS float* tot = (LAS float*)F.lds;
    LAS bf16* KhT = (LAS bf16*)(F.lds + 2048);
    LAS bf16* Vs = (LAS bf16*)(F.lds + 2048 + 18432);
    const int tid = F.tid, lane = F.lane, k = tid & 127, tg = tid >> 7, hi = lane >> 5;
    const float* gp = F.GL + (r0 + tg * 16) * 512 + h * 128 + k;
    float gv[16], cs[16]; float run = 0.f;
#pragma unroll
    for (int i = 0; i < 16; ++i) gv[i] = gp[(size_t)i * 512];
    v4u vreg[2];
#pragma unroll
    for (int i = 0; i < 2; ++i) { const int idx = tid + 512 * i, s = idx >> 4, ch = idx & 15; vreg[i] = *(const v4u*)(F.VL + (r0 + s) * 512 + h * 128 + ch * 8); }
#pragma unroll
    for (int i = 0; i < 16; ++i) { run += gv[i]; cs[i] = run; }
    tot[tg * 128 + k] = run;
    __syncthreads();
    const float t0 = tot[k], t1 = tot[128 + k], t2 = tot[256 + k], t3 = tot[384 + k];
    const float prefix = (tg > 0 ? t0 : 0.f) + (tg > 1 ? t1 : 0.f) + (tg > 2 ? t2 : 0.f), total = (t0 + t1) + (t2 + t3);
    unsigned pk[8];
#pragma unroll
    for (int i = 0; i < 16; i += 2) {
        const float a = (1.0f - __expf(gv[i])) * __expf(total - (prefix + cs[i])), bq = (1.0f - __expf(gv[i + 1])) * __expf(total - (prefix + cs[i + 1]));
        pk[i >> 1] = pg8::cvt_pk_bf16(a, bq); }
    *(LAS v4u*)(KhT + k * 72 + tg * 16) = (v4u){pk[0], pk[1], pk[2], pk[3]};
    *(LAS v4u*)(KhT + k * 72 + tg * 16 + 8) = (v4u){pk[4], pk[5], pk[6], pk[7]};
#pragma unroll
    for (int i = 0; i < 2; ++i) { const int idx = tid + 512 * i, s = idx >> 4, ch = idx & 15; *(LAS v4u*)(Vs + s * 144 + ch * 8) = vreg[i]; }
    if (tg == 0) F.DC[unit * 128 + k] = __expf(total);
    __syncthreads();
    const int w = F.wave, kt = w >> 1, g4 = lane >> 4, i16 = lane & 15;
#pragma unroll
    for (int vv = 0; vv < 2; ++vv) { const int vt = (w & 1) * 2 + vv;
        f32x16 acc = {};
#pragma unroll
        for (int ks = 0; ks < 4; ++ks) {
            const bf16x8 A = *(const LAS bf16x8*)(KhT + (32 * kt + (lane & 31)) * 72 + 16 * ks + 8 * hi);
            const int rowb = 16 * ks + 8 * (g4 >> 1) + (i16 >> 2), col = 32 * vt + 16 * (g4 & 1) + 4 * (i16 & 3);
            const bf16x8 B = trpair(Vs + rowb * 144 + col, Vs + (rowb + 4) * 144 + col);
            acc = __builtin_amdgcn_mfma_f32_32x32x16_bf16(A, B, acc, 0, 0, 0); }
        float* Lp = F.L + ((size_t)unit * 128 + 32 * kt) * 128 + 32 * vt + (lane & 31);
#pragma unroll
        for (int r = 0; r < 16; ++r) Lp[(size_t)crow(r, hi) * 128] = acc[r];
    }
    __syncthreads();
}
__device__ __forceinline__ void km_unit(Frame& F, int unit) {
    LAS float* red = (LAS float*)F.lds;
    const int tid = F.tid, c4 = tid & 127, rq = tid >> 7;
    const float* kp = F.out + O_KP + ((size_t)unit * 64 + rq * 16) * 512 + c4 * 4;
    f32x4 s = {0.f, 0.f, 0.f, 0.f};
#pragma unroll
    for (int i = 0; i < 16; ++i) s += *(const f32x4*)(kp + (size_t)i * 512);
    *(LAS f32x4*)(red + rq * 512 + c4 * 4) = s;
    __syncthreads();
    F.KMP[(size_t)unit * 512 + tid] = (red[tid] + red[512 + tid]) + (red[1024 + tid] + red[1536 + tid]);
    __syncthreads();
}
__device__ __forceinline__ void sh_unit(Frame& F, int unit) {
    const int h = unit & 3, b = unit >> 2, tid = F.tid, lane = F.lane;
    LAS float* fv = (LAS float*)F.lds;
    LAS float* kv = fv + 512; LAS float* qv = fv + 1024; LAS float* vv = fv + 1536;
    LAS float* part = fv + 2048;
    LAS float* red = part + 8192;
    { const int t = tid >> 7, k = tid & 127; const size_t row = (size_t)MP + b * 4 + t; const size_t o = row * 512 + h * 128 + k;
      const float f = __expf(F.GL[o]); fv[tid] = f; kv[tid] = 1.0f - f; qv[tid] = bf2f(F.QL[o]); vv[tid] = bf2f(F.VL[o]); }
    const int kq = tid >> 5, v4 = tid & 31;
    const size_t sbase = ((size_t)unit * 128 + 8 * kq) * 128 + 4 * v4;
    f32x4 S[8];
#pragma unroll
    for (int i = 0; i < 8; ++i) S[i] = *(const f32x4*)(F.state + sbase + (size_t)i * 128);
    __syncthreads();
#pragma unroll
    for (int t = 0; t < 4; ++t) { const f32x4 vt = *(const LAS f32x4*)(vv + t * 128 + 4 * v4); f32x4 po = {0.f, 0.f, 0.f, 0.f};
#pragma unroll
        for (int i = 0; i < 8; ++i) { const int k = 8 * kq + i; const float f = fv[t * 128 + k], kk = kv[t * 128 + k], q = qv[t * 128 + k];
            S[i] = S[i] * f + vt * kk; po += S[i] * q; }
        *(LAS f32x4*)(part + (t * 16 + kq) * 128 + 4 * v4) = po; }
#pragma unroll
    for (int i = 0; i < 8; ++i) *(f32x4*)(F.out + O_SS + sbase + (size_t)i * 128) = S[i];
    __syncthreads();
    { const int t = tid >> 7, v = tid & 127; float o = 0.f;
#pragma unroll
      for (int q = 0; q < 16; ++q) o += part[(t * 16 + q) * 128 + v];
      const float ss = wave_sum(o * o);
      if (lane == 0) red[F.wave] = ss;
      __syncthreads();
      const float rstd = 1.0f / sqrtf((red[2 * t] + red[2 * t + 1]) * (1.f / 128.f) + EPSN);
      const size_t row = (size_t)MP + b * 4 + t;
      const float y = o * rstd * F.norm_lin[v] * bf2f(F.GTL[row * 512 + h * 128 + v]);
      F.OMIX[row * 1024 + h * 128 + v] = (bf16)f2bf(y); }
    __syncthreads();
}
__device__ __forceinline__ float red16x4(float d0, float d1, float d2, float d3, int lane) {
    const bool o1 = lane & 1, o2 = lane & 2;
    const float s0 = o1 ? d0 : d2, s1 = o1 ? d1 : d3, k0 = o1 ? d2 : d0, k1 = o1 ? d3 : d1;
    const float a0 = k0 + __shfl_xor(s0, 1), a1 = k1 + __shfl_xor(s1, 1);
    const float s = o2 ? a0 : a1, kk = o2 ? a1 : a0;
    float r = kk + __shfl_xor(s, 2);
    r += __shfl_xor(r, 4); r += __shfl_xor(r, 8);
    return r;
}
typedef float f32x4m __attribute__((ext_vector_type(4)));
typedef unsigned u32x2m __attribute__((ext_vector_type(2)));
__device__ __forceinline__ void sat_unit(Frame& F, int unit) {
    const int hg = unit & 1, b = unit >> 1, tid = F.tid, lane = F.lane, w = F.wave;
    const int hl = w & 3, ph = w >> 2, hh = 4 * hg + hl, l15 = lane & 15, g = lane >> 4;
    LAS bf16* P = (LAS bf16*)F.lds;
    LAS float* tabs = (LAS float*)(F.lds + 65536);
    LAS bf16* Vt = (LAS bf16*)(F.lds + 78464) + w * 2304;
    LAS float* gl = (LAS float*)(F.lds + 115328);
    LAS unsigned* selm = (LAS unsigned*)(F.lds + 117888);
    LAS float* Ltot = (LAS float*)(F.lds + 117952);
    LAS float* pown = (LAS float*)(F.lds + 118016);
    LAS float* vnew = (LAS float*)(F.lds + 118272);
    LAS float* ored = (LAS float*)(F.lds + 122368);
    for (int i = tid; i < 4 * 808; i += NTHR) { const int t = i / 808, d = i - t * 808; tabs[i] = F.TAB[(4 * hg + t) * 4096 + d]; }
    for (int i = tid; i < 1024; i += NTHR) { const int key = i >> 8, t = (i >> 6) & 3, d = i & 63; vnew[i] = bf2f(F.VA[((size_t)MP + b * 4 + key) * 512 + (4 * hg + t) * 64 + d]); }
    const bool writer = l15 < 4;
    const int q = l15 & 3, hqw = hl * 4 + q;
    bf16x8 qb0 = {}, qb1 = {};
    if (writer) { const bf16* qp = F.QA + ((size_t)MP + b * 4 + q) * 512 + hh * 64 + 8 * g;
        qb0 = *(const bf16x8*)qp; qb1 = *(const bf16x8*)(qp + 32); }
    __syncthreads();
    const LAS float* tb = tabs + hl * 808;
#define SAT_LOADK(dst, pgv, st0) do { const float* kb_ = F.cache_k + (size_t)(pgv) * 128 * 512 + hh * 64 + (size_t)pr * 512 + 4 * c4 + (size_t)(st0) * 32 * 512; \
        _Pragma("unroll") for (int i = 0; i < 8; ++i) dst[i] = __builtin_nontemporal_load((const f32x4*)(kb_ + (size_t)(4 * i) * 512)); } while (0)
#define SAT_COMPK(src, jj, st0) do { \
        _Pragma("unroll") for (int i = 0; i < 8; ++i) { u32x2m pw; pw.x = pg8::cvt_pk_bf16(src[i].x, src[i].y); pw.y = pg8::cvt_pk_bf16(src[i].z, src[i].w); \
            *(LAS u32x2m*)(Vt + (4 * i + pr) * 72 + 4 * c4) = pw; } \
        _Pragma("unroll") for (int u = 0; u < 2; ++u) { \
            const bf16x8 a0 = *(const LAS bf16x8*)(Vt + (16 * u + l15) * 72 + 8 * g), a1 = *(const LAS bf16x8*)(Vt + (16 * u + l15) * 72 + 32 + 8 * g); \
            f32x4m acc = {0.f, 0.f, 0.f, 0.f}; \
            acc = __builtin_amdgcn_mfma_f32_16x16x32_bf16(a0, qb0, acc, 0, 0, 0); \
            acc = __builtin_amdgcn_mfma_f32_16x16x32_bf16(a1, qb1, acc, 0, 0, 0); \
            if (writer) { const int pos = 256 * (jj) + 128 * ph + 32 * (st0) + 16 * u + 4 * g; const int d0 = PASTLEN + q - pos; float p[4]; \
                _Pragma("unroll") for (int r = 0; r < 4; ++r) { const int dd = d0 - r; p[r] = ex2(acc[r] + tb[dd < 800 ? dd : 800]); } \
                gacc += (acc[0] + acc[1]) + (acc[2] + acc[3]); lacc += (p[0] + p[1]) + (p[2] + p[3]); \
                u32x2m pw; pw.x = pg8::cvt_pk_bf16(p[0], p[1]); pw.y = pg8::cvt_pk_bf16(p[2], p[3]); \
                *(LAS u32x2m*)(P + hqw * 2048 + pos) = pw; } } } while (0)
    const int pr = lane >> 4, c4 = lane & 15, i16 = lane & 15;
    {
        f32x4 KX[8], KY[8];
        int pg = F.page_table[b * 16 + ph];
        SAT_LOADK(KX, pg, 0);
        for (int j = 0; j < 8; ++j) {
            const int pgn = F.page_table[b * 16 + 2 * (j < 7 ? j + 1 : 7) + ph];
            float gacc = 0.f, lacc = 0.f;
            SAT_LOADK(KY, pg, 1); SAT_COMPK(KX, j, 0);
            SAT_LOADK(KX, pg, 2); SAT_COMPK(KY, j, 1);
            SAT_LOADK(KY, pg, 3); SAT_COMPK(KX, j, 2);
            if (j < 7) SAT_LOADK(KX, pgn, 0);
            SAT_COMPK(KY, j, 3);
            gacc += __shfl_xor(gacc, 16); gacc += __shfl_xor(gacc, 32); lacc += __shfl_xor(lacc, 16); lacc += __shfl_xor(lacc, 32);
            if (lane < 4) { gl[((j * 8 + w) * 4 + lane) * 2] = gacc; gl[((j * 8 + w) * 4 + lane) * 2 + 1] = lacc; }
            pg = pgn;
        }
    }
#undef SAT_LOADK
#undef SAT_COMPK
    __syncthreads();
    if (tid < 16) { const int hq = tid, qq = hq & 3, t = hq >> 2, h2 = 4 * hg + t;
        float gt[8], ls[8];
#pragma unroll
        for (int i = 0; i < 8; ++i) { gt[i] = gl[((i * 8 + t) * 4 + qq) * 2] + gl[((i * 8 + t + 4) * 4 + qq) * 2]; ls[i] = gl[((i * 8 + t) * 4 + qq) * 2 + 1] + gl[((i * 8 + t + 4) * 4 + qq) * 2 + 1]; }
        const unsigned mask = top3mask8(gt);
        float Lt = 0.f;
#pragma unroll
        for (int i = 0; i < 8; ++i) if ((mask >> i) & 1u) Lt += ls[i];
        const v4u* qp = (const v4u*)(F.QA + ((size_t)MP + b * 4 + qq) * 512 + h2 * 64);
        v4u qw[8];
#pragma unroll
        for (int c = 0; c < 8; ++c) qw[c] = qp[c];
#pragma unroll
        for (int i = 0; i < 4; ++i) { float p = 0.f;
            if (i <= qq) { const v4u* kp = (const v4u*)(F.KA + ((size_t)MP + b * 4 + i) * 512 + h2 * 64); float s = 0.f;
#pragma unroll
                for (int c = 0; c < 8; ++c) { const v4u kw = kp[c];
                    s += (bflo(qw[c].x) * bflo(kw.x) + bfhi(qw[c].x) * bfhi(kw.x)) + (bflo(qw[c].y) * bflo(kw.y) + bfhi(qw[c].y) * bfhi(kw.y))
                       + (bflo(qw[c].z) * bflo(kw.z) + bfhi(qw[c].z) * bfhi(kw.z)) + (bflo(qw[c].w) * bflo(kw.w) + bfhi(qw[c].w) * bfhi(kw.w)); }
                p = ex2(s + F.TAB[h2 * 4096 + (qq - i)]); }
            pown[hq * 4 + i] = p; Lt += p; }
        selm[hq] = mask; Ltot[hq] = Lt; }
    __syncthreads();
    f32x4m oacc[4];
#pragma unroll
    for (int dt = 0; dt < 4; ++dt) oacc[dt] = (f32x4m){0.f, 0.f, 0.f, 0.f};
    const unsigned many = selm[hl * 4] | selm[hl * 4 + 1] | selm[hl * 4 + 2] | selm[hl * 4 + 3];
    const unsigned mymask = writer ? selm[hqw] : 0u;
#define SAT_LOADV(dst, pgv, st0) do { const float* vb_ = F.cache_v + (size_t)(pgv) * 128 * 512 + hh * 64 + (size_t)pr * 512 + 4 * c4 + (size_t)(st0) * 32 * 512; \
        _Pragma("unroll") for (int i = 0; i < 8; ++i) dst[i] = __builtin_nontemporal_load((const f32x4*)(vb_ + (size_t)(4 * i) * 512)); } while (0)
#define SAT_COMPV(src, jj, st0) do { const bool mysel = (mymask >> (jj)) & 1u; { \
        _Pragma("unroll") for (int i = 0; i < 8; ++i) { u32x2m pw; pw.x = pg8::cvt_pk_bf16(src[i].x, src[i].y); pw.y = pg8::cvt_pk_bf16(src[i].z, src[i].w); \
            *(LAS u32x2m*)(Vt + (4 * i + pr) * 72 + 4 * c4) = pw; } \
        const int pos = 256 * (jj) + 128 * ph + 32 * (st0) + 8 * g; \
        v4u bw = *(const LAS v4u*)(P + hqw * 2048 + pos); \
        if (!mysel) bw = (v4u){0u, 0u, 0u, 0u}; \
        const bf16x8 B = __builtin_bit_cast(bf16x8, bw); \
        _Pragma("unroll") for (int dt = 0; dt < 4; ++dt) { \
            const bf16x8 A = trpair(Vt + (8 * g + (i16 >> 2)) * 72 + 16 * dt + 4 * (i16 & 3), Vt + (8 * g + 4 + (i16 >> 2)) * 72 + 16 * dt + 4 * (i16 & 3)); \
            oacc[dt] = __builtin_amdgcn_mfma_f32_16x16x32_bf16(A, B, oacc[dt], 0, 0, 0); } } } while (0)
    {
        unsigned rem = many & 0xffu;
        if (rem) {
            f32x4 VX[8], VY[8];
            int j = __builtin_ctz(rem); rem &= rem - 1u;
            int pg = F.page_table[b * 16 + 2 * j + ph];
            SAT_LOADV(VX, pg, 0);
            for (;;) {
                SAT_LOADV(VY, pg, 1); SAT_COMPV(VX, j, 0);
                SAT_LOADV(VX, pg, 2); SAT_COMPV(VY, j, 1);
                SAT_LOADV(VY, pg, 3); SAT_COMPV(VX, j, 2);
                const bool more = rem != 0u; int jn = 0, pgn = 0;
                if (more) { jn = __builtin_ctz(rem); rem &= rem - 1u; pgn = F.page_table[b * 16 + 2 * jn + ph]; SAT_LOADV(VX, pgn, 0); }
                SAT_COMPV(VY, j, 3);
                if (!more) break;
                j = jn; pg = pgn;
            }
        }
    }
#undef SAT_LOADV
#undef SAT_COMPV
    if (writer) {
#pragma unroll
        for (int dt = 0; dt < 4; ++dt)
#pragma unroll
            for (int r = 0; r < 4; ++r) { const int d = 16 * dt + 4 * g + r; float o = oacc[dt][r];
                if (ph == 0) {
#pragma unroll
                    for (int i = 0; i < 4; ++i) o += pown[hqw * 4 + i] * vnew[(i * 4 + hl) * 64 + d]; }
                ored[(w * 4 + q) * 64 + d] = o; }
    }
    __syncthreads();
#pragma unroll
    for (int i = 0; i < 2; ++i) { const int idx = tid + 512 * i, hq = idx >> 6, d = idx & 63, qq = hq & 3, t = hq >> 2, h2 = 4 * hg + t;
        const float s = ored[(t * 4 + qq) * 64 + d] + ored[((t + 4) * 4 + qq) * 64 + d];
        const size_t row = (size_t)MP + b * 4 + qq;
        const float y = s / Ltot[hq] * bf2f(F.GTA[row * 512 + h2 * 64 + d]);
        F.OMIX[row * 1024 + 512 + h2 * 64 + d] = (bf16)f2bf(y); }
    __syncthreads();
}
__device__ __forceinline__ void sg1_tile(Frame& F, int t, unsigned char* ws) {
    const int rt = t >> 5, ct = t & 31, w = F.wave, wr = w >> 2, wc = w & 3, lane = F.lane, l31 = lane & 31, hi = lane >> 5, tid = F.tid;
    LAS bf16* As = (LAS bf16*)F.lds;
    LAS bf16* Bs = As + 64 * 264;
    const bf16* Ag = F.H + (size_t)(MP + 64 * rt) * DM; const bf16* Bg = F.WIN + (size_t)(128 * ct) * DM;
    const int lrow = tid >> 5, lch = tid & 31;
    v4u ar[4], br[8];
#pragma unroll
    for (int i = 0; i < 4; ++i) ar[i] = *(const v4u*)(Ag + (size_t)(lrow + 16 * i) * DM + lch * 8);
#pragma unroll
    for (int i = 0; i < 8; ++i) br[i] = *(const v4u*)(Bg + (size_t)(lrow + 16 * i) * DM + lch * 8);
    f32x16 acc = {};
    for (int kc = 0; kc < 4; ++kc) {
#pragma unroll
        for (int i = 0; i < 4; ++i) *(LAS v4u*)(As + (lrow + 16 * i) * 264 + lch * 8) = ar[i];
#pragma unroll
        for (int i = 0; i < 8; ++i) *(LAS v4u*)(Bs + (lrow + 16 * i) * 264 + lch * 8) = br[i];
        __syncthreads();
        if (kc + 1 < 4) {
#pragma unroll
            for (int i = 0; i < 4; ++i) ar[i] = *(const v4u*)(Ag + (size_t)(lrow + 16 * i) * DM + (kc + 1) * 256 + lch * 8);
#pragma unroll
            for (int i = 0; i < 8; ++i) br[i] = *(const v4u*)(Bg + (size_t)(lrow + 16 * i) * DM + (kc + 1) * 256 + lch * 8);
        }
#pragma unroll
        for (int ks = 0; ks < 16; ++ks) {
            const bf16x8 a = *(const LAS bf16x8*)(As + (32 * wr + l31) * 264 + 16 * ks + 8 * hi), bb = *(const LAS bf16x8*)(Bs + (32 * wc + l31) * 264 + 16 * ks + 8 * hi);
            acc = __builtin_amdgcn_mfma_f32_32x32x16_bf16(a, bb, acc, 0, 0, 0); }
        __syncthreads();
    }
    const int col = 128 * ct + 32 * wc + l31, type = col >> 9, cin = col & 511;
    size_t bofs = WS_QL;
    switch (type) { case 0: bofs = WS_QL; break; case 2: bofs = WS_VL; break; case 3: bofs = WS_GTL; break; case 4: bofs = WS_QA; break; case 5: bofs = WS_KA; break; case 6: bofs = WS_VA; break; case 7: bofs = WS_GTA; break; default: break; }
    bf16* dstb = (bf16*)(ws + bofs);
    const float lbv = F.LB[cin];
#pragma unroll
    for (int r = 0; r < 16; ++r) { const int srow = 64 * rt + 32 * wr + crow(r, hi); const size_t row = (size_t)MP + srow; float v = acc[r];
        if (type == 0 || type == 3 || type == 7) v = v / (1.0f + __expf(-v));
        else if (type == 1) { const float s = 1.0f / (1.0f + __expf(-v)); v = __logf(lbv + (1.0f - lbv) * s); }
        else if (type == 4) v *= QSCALE;
        if (type == 1) F.GL[row * 512 + cin] = v;
        else dstb[row * 512 + cin] = (bf16)f2bf(v);
        if (type == 5) F.out[O_KS + (size_t)srow * 512 + cin] = v;
        if (type == 6) F.out[O_VS + (size_t)srow * 512 + cin] = v; }
}
__device__ __forceinline__ void hb_scan(Frame& F) {
    const int gt = F.bid * NTHR + F.tid, NGT = F.G * NTHR;
    for (int item = gt; item < 16 * 8192; item += NGT) {
        const int bh = item >> 13, e2 = item & 8191, k = e2 >> 6, v = (e2 & 63) * 2;
        f32x2 S = {0.f, 0.f};
        for (int c0 = 0; c0 < 64; c0 += 8) {
            f32x2 l[8]; float d[8];
#pragma unroll
            for (int u = 0; u < 8; ++u) { const size_t un = (size_t)bh * 64 + c0 + u; l[u] = *(const f32x2*)(F.L + (un * 128 + k) * 128 + v); d[u] = F.DC[un * 128 + k]; }
#pragma unroll
            for (int u = 0; u < 8; ++u) { const size_t un = (size_t)bh * 64 + c0 + u;
                *(unsigned*)(F.SC + (un * 128 + k) * 128 + v) = pg8::cvt_pk_bf16(S.x, S.y);
                S = S * d[u] + l[u]; }
        }
        *(f32x2*)(F.out + O_SP + ((size_t)bh * 128 + k) * 128 + v) = S;
    }
}
__device__ __forceinline__ void hc_unit(Frame& F, int unit) {
    const int c = unit & 63, bh = unit >> 6, h = bh & 3, b = bh >> 2;
    const size_t r0 = (size_t)b * SEQ + c * 64;
    LAS float* tot = (LAS float*)F.lds;
    LAS bf16* Qt = (LAS bf16*)(F.lds + 2048);
    LAS bf16* Qh = (LAS bf16*)(F.lds + 2048 + 17408);
    LAS bf16* Kt = (LAS bf16*)(F.lds + 2048 + 2 * 17408);
    LAS bf16* Vs = (LAS bf16*)(F.lds + 2048 + 3 * 17408);
    LAS bf16* Ss = (LAS bf16*)(F.lds + 2048 + 3 * 17408 + 18432);
    LAS float* Ob = (LAS float*)(F.lds + 2048);
    const int tid = F.tid, lane = F.lane, k = tid & 127, tg = tid >> 7, hi = lane >> 5;
    const float* gp = F.GL + (r0 + tg * 16) * 512 + h * 128 + k;
    const bf16* qp = F.QL + (r0 + tg * 16) * 512 + h * 128 + k;
    float gv[16], cs[16], qv[16]; float run = 0.f;
#pragma unroll
    for (int i = 0; i < 16; ++i) { gv[i] = gp[(size_t)i * 512]; qv[i] = bf2f(qp[(size_t)i * 512]); }
    v4u vreg[2], sreg[4];
#pragma unroll
    for (int i = 0; i < 2; ++i) { const int idx = tid + 512 * i, s = idx >> 4, ch = idx & 15; vreg[i] = *(const v4u*)(F.VL + (r0 + s) * 512 + h * 128 + ch * 8); }
#pragma unroll
    for (int i = 0; i < 4; ++i) { const int idx = tid + 512 * i, kr = idx >> 4, ch = idx & 15; sreg[i] = *(const v4u*)(F.SC + ((size_t)unit * 128 + kr) * 128 + ch * 8); }
#pragma unroll
    for (int i = 0; i < 16; ++i) { run += gv[i]; cs[i] = run; }
    tot[tg * 128 + k] = run;
    __syncthreads();
    const float t0 = tot[k], t1 = tot[128 + k], t2 = tot[256 + k];
    const float prefix = (tg > 0 ? t0 : 0.f) + (tg > 1 ? t1 : 0.f) + (tg > 2 ? t2 : 0.f), rref = t0 + t1;
#pragma unroll
    for (int i = 0; i < 16; ++i) { const float bi = prefix + cs[i], kk = 1.0f - __expf(gv[i]); const int t = tg * 16 + i;
        Qt[t * 136 + k] = (bf16)f2bf(qv[i] * __expf(bi - rref)); Qh[t * 136 + k] = (bf16)f2bf(qv[i] * __expf(bi)); Kt[t * 136 + k] = (bf16)f2bf(kk * __expf(rref - bi)); }
#pragma unroll
    for (int i = 0; i < 2; ++i) { const int idx = tid + 512 * i, s = idx >> 4, ch = idx & 15; *(LAS v4u*)(Vs + s * 144 + ch * 8) = vreg[i]; }
#pragma unroll
    for (int i = 0; i < 4; ++i) { const int idx = tid + 512 * i, kr = idx >> 4, ch = idx & 15; *(LAS v4u*)(Ss + kr * 144 + ch * 8) = sreg[i]; }
    __syncthreads();
    const int w = F.wave, tt = w >> 2, vt = w & 3, g4 = lane >> 4, i16 = lane & 15, l31 = lane & 31;
    f32x16 o = {};
    for (int st = 0; st <= tt; ++st) {
        f32x16 a = {};
#pragma unroll
        for (int kk = 0; kk < 8; ++kk) {
            const bf16x8 A = *(const LAS bf16x8*)(Kt + (32 * st + l31) * 136 + 16 * kk + 8 * hi);
            const bf16x8 B = *(const LAS bf16x8*)(Qt + (32 * tt + l31) * 136 + 16 * kk + 8 * hi);
            a = __builtin_amdgcn_mfma_f32_32x32x16_bf16(A, B, a, 0, 0, 0); }
        if (st == tt) {
#pragma unroll
            for (int r = 0; r < 16; ++r) if (crow(r, hi) > l31) a[r] = 0.f; }
#pragma unroll
        for (int s2 = 0; s2 < 2; ++s2) {
            const bf16x8 pa = pack8(a[8 * s2], a[8 * s2 + 1], a[8 * s2 + 2], a[8 * s2 + 3], a[8 * s2 + 4], a[8 * s2 + 5], a[8 * s2 + 6], a[8 * s2 + 7]);
            const int rowb = 32 * st + 16 * s2 + 4 * (g4 >> 1) + (i16 >> 2), col = 32 * vt + 16 * (g4 & 1) + 4 * (i16 & 3);
            const bf16x8 B = trpair(Vs + rowb * 144 + col, Vs + (rowb + 8) * 144 + col);
            o = __builtin_amdgcn_mfma_f32_32x32x16_bf16(pa, B, o, 0, 0, 0); }
    }
#pragma unroll
    for (int kk = 0; kk < 8; ++kk) {
        const bf16x8 A = *(const LAS bf16x8*)(Qh + (32 * tt + l31) * 136 + 16 * kk + 8 * hi);
        const int rowb = 16 * kk + 8 * (g4 >> 1) + (i16 >> 2), col = 32 * vt + 16 * (g4 & 1) + 4 * (i16 & 3);
        const bf16x8 B = trpair(Ss + rowb * 144 + col, Ss + (rowb + 4) * 144 + col);
        o = __builtin_amdgcn_mfma_f32_32x32x16_bf16(A, B, o, 0, 0, 0); }
    __syncthreads();
#pragma unroll
    for (int r = 0; r < 16; ++r) Ob[(32 * tt + crow(r, hi)) * 132 + 32 * vt + l31] = o[r];
    __syncthreads();
    { const int t = tid >> 3, vc = (tid & 7) * 16; float x[16]; float ss = 0.f;
#pragma unroll
      for (int i = 0; i < 16; i += 4) { const f32x4 q = *(const LAS f32x4*)(Ob + t * 132 + vc + i); x[i] = q.x; x[i + 1] = q.y; x[i + 2] = q.z; x[i + 3] = q.w; ss += (q.x * q.x + q.y * q.y) + (q.z * q.z + q.w * q.w); }
      ss += __shfl_xor(ss, 1); ss += __shfl_xor(ss, 2); ss += __shfl_xor(ss, 4);
      const float rstd = 1.0f / sqrtf(ss * (1.f / 128.f) + EPSN);
      const v4u g0 = *(const v4u*)(F.GTL + (r0 + t) * 512 + h * 128 + vc), g1 = *(const v4u*)(F.GTL + (r0 + t) * 512 + h * 128 + vc + 8);
      const unsigned gw[8] = {g0.x, g0.y, g0.z, g0.w, g1.x, g1.y, g1.z, g1.w};
      unsigned ow[8];
#pragma unroll
      for (int i = 0; i < 8; ++i) { const float a = x[2 * i] * rstd * F.norm_lin[vc + 2 * i] * bflo(gw[i]), bq = x[2 * i + 1] * rstd * F.norm_lin[vc + 2 * i + 1] * bfhi(gw[i]); ow[i] = pg8::cvt_pk_bf16(a, bq); }
      bf16* op = F.OMIX + (r0 + t) * 1024 + h * 128 + vc;
      *(v4u*)op = (v4u){ow[0], ow[1], ow[2], ow[3]}; *(v4u*)(op + 8) = (v4u){ow[4], ow[5], ow[6], ow[7]}; }
    __syncthreads();
}
__device__ __forceinline__ void pa_unit(Frame& F, int b, int h, int o) {
    constexpr int KSZ = 64 * 72;
    LAS bf16* Ks = (LAS bf16*)F.lds;
    LAS bf16* Vs = Ks + 2 * KSZ;
    LAS float* T2 = (LAS float*)(F.lds + 4 * KSZ * 2);
    LAS float* km = T2 + 4096;
    LAS unsigned* sel = (LAS unsigned*)(km + 1024);
    const int tid = F.tid, lane = F.lane, w = F.wave, hi = lane >> 5, l31 = lane & 31, g4 = lane >> 4, i16 = lane & 15;
    const size_t rb = (size_t)b * SEQ;
    for (int i = tid; i < 4096; i += NTHR) T2[i] = F.TAB[h * 4096 + i];
    for (int i = tid; i < 1024; i += NTHR) { const int j = i >> 6, d = i & 63; const float* kp = F.KMP + ((size_t)(b * 64 + 4 * j)) * 512 + h * 64 + d;
        km[i] = (kp[0] + kp[512]) + (kp[1024] + kp[1536]); }
    __syncthreads();
    if (tid < 256) {
        const bf16* qp = F.QA + (rb + 256 * o + tid) * 512 + h * 64;
        float qf[64];
#pragma unroll
        for (int i = 0; i < 8; ++i) { const v4u q = *(const v4u*)(qp + 8 * i); qf[8 * i] = bflo(q.x); qf[8 * i + 1] = bfhi(q.x); qf[8 * i + 2] = bflo(q.y); qf[8 * i + 3] = bfhi(q.y);
            qf[8 * i + 4] = bflo(q.z); qf[8 * i + 5] = bfhi(q.z); qf[8 * i + 6] = bflo(q.w); qf[8 * i + 7] = bfhi(q.w); }
        float b1 = -INFINITY, b2 = -INFINITY, b3 = -INFINITY; int i1 = -1, i2 = -1, i3 = -1;
        for (int j = 0; j < o; ++j) { float g = 0.f;
#pragma unroll
            for (int d = 0; d < 64; d += 4) { const f32x4 kq = *(const LAS f32x4*)(km + j * 64 + d); g += (qf[d] * kq.x + qf[d + 1] * kq.y) + (qf[d + 2] * kq.z + qf[d + 3] * kq.w); }
            if (g > b1) { b3 = b2; i3 = i2; b2 = b1; i2 = i1; b1 = g; i1 = j; } else if (g > b2) { b3 = b2; i3 = i2; b2 = g; i2 = j; } else if (g > b3) { b3 = g; i3 = j; } }
        sel[tid] = (i1 >= 0 ? 1u << i1 : 0u) | (i2 >= 0 ? 1u << i2 : 0u) | (i3 >= 0 ? 1u << i3 : 0u);
    }
    const int qloc = 32 * w + l31; const size_t qrow = rb + 256 * o + qloc;
    bf16x8 qf4[4];
#pragma unroll
    for (int d0 = 0; d0 < 4; ++d0) qf4[d0] = *(const bf16x8*)(F.QA + qrow * 512 + h * 64 + 16 * d0 + 8 * hi);
    const int ntiles = 4 + 4 * o;
    const int skv = tid >> 3, sch = tid & 7;
    v4u kreg, vreg;
    { const int kvb = 256 * o; kreg = *(const v4u*)(F.KA + (rb + kvb + skv) * 512 + h * 64 + sch * 8); vreg = *(const v4u*)(F.VA + (rb + kvb + skv) * 512 + h * 64 + sch * 8); }
    *(LAS v4u*)(Ks + skv * 72 + sch * 8) = kreg; *(LAS v4u*)(Vs + skv * 72 + sch * 8) = vreg;
    __syncthreads();
    const unsigned selm = sel[qloc];
    const int qpos = 256 * o + qloc;
    const float cfar = T2[4095];
    float l = 0.f; f32x16 oa0 = {}, oa1 = {};
    for (int ti = 0; ti < ntiles; ++ti) {
        const int buf = ti & 1;
        if (ti + 1 < ntiles) { const int tn = ti + 1, kvn = tn < 4 ? 256 * o + 64 * tn : 64 * (tn - 4);
            kreg = *(const v4u*)(F.KA + (rb + kvn + skv) * 512 + h * 64 + sch * 8); vreg = *(const v4u*)(F.VA + (rb + kvn + skv) * 512 + h * 64 + sch * 8); }
        const bool own = ti < 4; const int kvb = own ? 256 * o + 64 * ti : 64 * (ti - 4); const int jb = own ? 0 : (ti - 4) >> 2;
        const bool rowsel = own || ((selm >> jb) & 1u);
        const bool active = own ? (ti <= (w >> 1)) : (__any(rowsel) != 0);
        if (active) {
            const LAS bf16* Kb = Ks + buf * KSZ; const LAS bf16* Vb = Vs + buf * KSZ;
            const bool far = (256 * o + 32 * w) - (kvb + 63) >= 800;
            const float cinit = (rowsel ? 0.f : NEGBIG) + (far ? cfar : 0.f);
            f32x16 p0, p1;
#pragma unroll
            for (int r = 0; r < 16; ++r) { p0[r] = cinit; p1[r] = cinit; }
#pragma unroll
            for (int d0 = 0; d0 < 4; ++d0) {
                const bf16x8 a0 = *(const LAS bf16x8*)(Kb + l31 * 72 + 16 * d0 + 8 * hi), a1 = *(const LAS bf16x8*)(Kb + (32 + l31) * 72 + 16 * d0 + 8 * hi);
                p0 = __builtin_amdgcn_mfma_f32_32x32x16_bf16(a0, qf4[d0], p0, 0, 0, 0); p1 = __builtin_amdgcn_mfma_f32_32x32x16_bf16(a1, qf4[d0], p1, 0, 0, 0); }
            const int dbase = qpos - kvb - 4 * hi;
            if (!far) {
                const LAS float* T2p = T2 + (dbase - 59);
#pragma unroll
                for (int r = 0; r < 16; ++r) { const int c = (r & 3) + 8 * (r >> 2); p0[r] += T2p[59 - c]; p1[r] += T2p[27 - c]; }
                if (own) {
#pragma unroll
                    for (int r = 0; r < 16; ++r) { const int c = (r & 3) + 8 * (r >> 2); if (dbase - c < 0) p0[r] = NEGBIG; if (dbase - c - 32 < 0) p1[r] = NEGBIG; }
                }
            }
            float rs = 0.f;
#pragma unroll
            for (int r = 0; r < 16; ++r) { p0[r] = ex2(p0[r]); p1[r] = ex2(p1[r]); rs += p0[r] + p1[r]; }
            l += rs;
            const bf16x8 pb0 = pack8(p0[0], p0[1], p0[2], p0[3], p0[4], p0[5], p0[6], p0[7]), pb1 = pack8(p0[8], p0[9], p0[10], p0[11], p0[12], p0[13], p0[14], p0[15]);
            const bf16x8 pb2 = pack8(p1[0], p1[1], p1[2], p1[3], p1[4], p1[5], p1[6], p1[7]), pb3 = pack8(p1[8], p1[9], p1[10], p1[11], p1[12], p1[13], p1[14], p1[15]);
#define PA_PV(s, PB) do { const int rowb = 16 * (s) + 4 * (g4 >> 1) + (i16 >> 2), col = 16 * (g4 & 1) + 4 * (i16 & 3); \
                const bf16x8 va0 = trpair(Vb + rowb * 72 + col, Vb + (rowb + 8) * 72 + col), va1 = trpair(Vb + rowb * 72 + 32 + col, Vb + (rowb + 8) * 72 + 32 + col); \
                oa0 = __builtin_amdgcn_mfma_f32_32x32x16_bf16(va0, PB, oa0, 0, 0, 0); oa1 = __builtin_amdgcn_mfma_f32_32x32x16_bf16(va1, PB, oa1, 0, 0, 0); } while (0)
            PA_PV(0, pb0); PA_PV(1, pb1); PA_PV(2, pb2); PA_PV(3, pb3);
#undef PA_PV
        }
        if (ti + 1 < ntiles) { *(LAS v4u*)(Ks + (buf ^ 1) * KSZ + skv * 72 + sch * 8) = kreg; *(LAS v4u*)(Vs + (buf ^ 1) * KSZ + skv * 72 + sch * 8) = vreg; }
        __syncthreads();
    }
    l += __shfl_xor(l, 32);
    const float inv = 1.0f / l;
#pragma unroll
    for (int dh = 0; dh < 2; ++dh)
#pragma unroll
        for (int rg = 0; rg < 4; ++rg) { const int d0 = 32 * dh + 8 * rg + 4 * hi;
            const uint2 gw = *(const uint2*)(F.GTA + qrow * 512 + h * 64 + d0);
            const float x0 = (dh ? oa1[4 * rg] : oa0[4 * rg]) * inv * bflo(gw.x), x1 = (dh ? oa1[4 * rg + 1] : oa0[4 * rg + 1]) * inv * bfhi(gw.x);
            const float x2 = (dh ? oa1[4 * rg + 2] : oa0[4 * rg + 2]) * inv * bflo(gw.y), x3 = (dh ? oa1[4 * rg + 3] : oa0[4 * rg + 3]) * inv * bfhi(gw.y);
            uint2 ow; ow.x = pg8::cvt_pk_bf16(x0, x1); ow.y = pg8::cvt_pk_bf16(x2, x3);
            *(uint2*)(F.OMIX + qrow * 1024 + 512 + h * 64 + d0) = ow; }
    __syncthreads();
}
__device__ __forceinline__ void p6_row(Frame& F, int m) {
    const GAS f32x4* orow = (const GAS f32x4*)(F.O2 + (size_t)m * DM) + F.lane; const GAS f32x4* gr = (const GAS f32x4*)F.norm_post + F.lane;
    const GAS f32x4* xr = (const GAS f32x4*)(m < MP ? F.xp + (size_t)m * DM : F.xs + (size_t)(m - MP) * DM) + F.lane;
    GAS f32x4* yr = (GAS f32x4*)(m < MP ? F.out + O_YP + (size_t)m * DM : F.out + O_YS + (size_t)(m - MP) * DM) + F.lane;
    f32x4 v[4]; float s = 0.f;
#pragma unroll
    for (int j = 0; j < 4; ++j) { v[j] = orow[64 * j]; s += (v[j].x * v[j].x + v[j].y * v[j].y) + (v[j].z * v[j].z + v[j].w * v[j].w); }
    const float rstd = 1.0f / sqrtf(wave_sum(s) * (1.f / DM) + EPSN);
#pragma unroll
    for (int j = 0; j < 4; ++j) yr[64 * j] = xr[64 * j] + v[j] * rstd * gr[64 * j];
}

#ifndef MK_PER_PHASE
#define MK_PER_PHASE 0
#endif
constexpr int N_PHASES = 7;
#ifndef REP_SAT
#define REP_SAT 1
#endif
#ifndef REP_PA
#define REP_PA 1
#endif
#ifndef REP_P1
#define REP_P1 1
#endif
#ifndef REP_P2
#define REP_P2 1
#endif
#ifndef REP_P3
#define REP_P3 1
#endif
#ifndef REP_P4
#define REP_P4 1
#endif
struct Args { const void* in[13]; float* out; unsigned char* ws; int ph_lo, ph_hi; };
__global__ void __launch_bounds__(NWAVES * 64, 2) hymba_fwd(Args args) {
    extern __shared__ __attribute__((aligned(16))) unsigned char lds[];
    Frame F;
    F.lds = (LAS unsigned char*)lds;
    F.MISC = (volatile LAS unsigned*)(F.lds + MISC_OFF);
    F.tid = threadIdx.x; F.lane = F.tid & 63; F.wave = __builtin_amdgcn_readfirstlane(F.tid >> 6);
    F.G = gridDim.x; F.bid = blockIdx.x;
    unsigned char* ws = args.ws;
    F.ctl = (gu32*)(ws + WS_CTL);
    F.xp = (const float*)args.in[0]; F.xs = (const float*)args.in[1]; F.cache_k = (const float*)args.in[2]; F.cache_v = (const float*)args.in[3]; F.state = (const float*)args.in[4];
    F.page_table = (const int*)args.in[5]; F.w_in = (const float*)args.in[6]; F.w_out = (const float*)args.in[7]; F.norm_pre = (const float*)args.in[8]; F.norm_post = (const float*)args.in[9];
    F.norm_lin = (const float*)args.in[10]; F.llb = (const float*)args.in[11]; F.rel_bias = (const float*)args.in[12]; F.out = args.out;
    F.WIN = (bf16*)(ws + WS_WIN); F.WOUT = (bf16*)(ws + WS_WOUT); F.H = (bf16*)(ws + WS_H); F.QL = (bf16*)(ws + WS_QL); F.VL = (bf16*)(ws + WS_VL); F.GTL = (bf16*)(ws + WS_GTL);
    F.QA = (bf16*)(ws + WS_QA); F.KA = (bf16*)(ws + WS_KA); F.VA = (bf16*)(ws + WS_VA); F.GTA = (bf16*)(ws + WS_GTA); F.SC = (bf16*)(ws + WS_SC); F.OMIX = (bf16*)(ws + WS_OMIX);
    F.TAB = (float*)(ws + WS_TAB); F.LB = (float*)(ws + WS_LB); F.KMP = (float*)(ws + WS_KMP); F.GATE = (float*)(ws + WS_GATE); F.ML = (float*)(ws + WS_ML); F.DC = (float*)(ws + WS_DC);
    F.GL = (float*)(ws + WS_GL); F.L = (float*)(ws + WS_L); F.LOG = (float*)(ws + WS_LOG); F.OPART = (float*)(ws + WS_OPART); F.O2 = (float*)(ws + WS_O2);
    for (int u = F.tid; u < (LDS_BYTES - LDSCTL_OFF) / 4; u += NWAVES * 64) ((LAS unsigned*)(F.lds + LDSCTL_OFF))[u] = 0u;
    __syncthreads();
    XcdBarrier bar; bar.bar = (unsigned*)(F.ctl + CW_BAR); bar.x = 0; bar.st = nullptr;
    if (!MK_PER_PHASE) bar = xcd_barrier_post((unsigned*)(F.ctl + CW_BAR), F.MISC + 8);
#define GRID_BAR() do { if (!MK_PER_PHASE) xcd_barrier(bar); } while (0)
    const int lo = args.ph_lo, hi = args.ph_hi;
#define IN(k) (lo <= (k) && (k) < hi)
#define BOTH(k) (IN(k) && IN((k) + 1))
    const int bid = F.bid, G = F.G;
    if (IN(0)) { p0_prologue(F); if (BOTH(0)) GRID_BAR(); }
    if (IN(1)) for (int rep = 0; rep < REP_P1; ++rep) {
        for (int t = bid; t < 256; t += G) sg1_tile(F, t, ws);
        pg8::Gemm g{F.H, F.WIN, MP, DIN, DM}; pg8::StaticOrder S; S.init(MP, DIN, G, bid);
        Epi1 E{ws, F.out, F.LB};
        pg8::gemm_phase<Epi1, pg8::StaticOrder, true, true>(F.lds + RING_OFF, g, S, E);
        if (BOTH(1)) GRID_BAR();
    }
    if (IN(2)) for (int rep = 0; rep < REP_P2; ++rep) {
        for (int u = bid; u < 1024; u += G) ha_unit(F, u);
        for (int u = bid; u < 256; u += G) km_unit(F, u);
        for (int u = bid; u < 512; u += G) sh_unit(F, u);
        if (BOTH(2)) GRID_BAR();
    }
    if (IN(3)) for (int rep = 0; rep < REP_P3; ++rep) {
        hb_scan(F);
        if (BOTH(3)) GRID_BAR();
    }
    if (IN(4)) for (int rep = 0; rep < REP_P4; ++rep) {
        const bool stream_first = ((bid >> 3) & 1) != 0;
        if (stream_first) for (int rs = 0; rs < REP_SAT; ++rs) for (int u = bid; u < 256; u += G) sat_unit(F, u);
        for (int rp = 0; rp < REP_PA; ++rp) for (int u = bid; u < 256; u += G) { const int bh = u >> 3, s = u & 7; pa_unit(F, bh >> 3, bh & 7, s); pa_unit(F, bh >> 3, bh & 7, 15 - s); }
        for (int u = bid; u < 1024; u += G) hc_unit(F, u);
        if (!stream_first) for (int rs = 0; rs < REP_SAT; ++rs) for (int u = bid; u < 256; u += G) sat_unit(F, u);
        if (BOTH(4)) GRID_BAR();
    }
    if (IN(5)) {
        pg8::Gemm g{F.OMIX, F.WOUT, MROWS, DM, DM}; pg8::StaticOrder S; S.init(MROWS, DM, G, bid);
        Epi2 E{F.O2};
        pg8::gemm_phase<Epi2, pg8::StaticOrder, true, true>(F.lds + RING_OFF, g, S, E);
        if (BOTH(5)) GRID_BAR();
    }
    if (IN(6)) { for (int m = bid * NWAVES + F.wave; m < MROWS; m += G * NWAVES) p6_row(F, m); }
#undef IN
#undef BOTH
}

extern "C" void kernel_launch(void* const* d_in, const int* in_sizes, int n_in, void* d_out, int out_size, void* d_ws, size_t ws_size, hipStream_t stream) {
    static int grid = 0;
    if (grid == 0) {
        if (n_in != 13 || (size_t)out_size != O_END || ws_size < WS_END) { fprintf(stderr, "kernel_launch: unexpected shapes (n_in %d out %d ws %zu)\n", n_in, out_size, ws_size); grid = -1; return; }
        int dev = 0, cus = 0, per_cu = 0;
        if (hipGetDevice(&dev) != hipSuccess || hipDeviceGetAttribute(&cus, hipDeviceAttributeMultiprocessorCount, dev) != hipSuccess) { grid = -1; return; }
        if (hipFuncSetAttribute((const void*)hymba_fwd, hipFuncAttributeMaxDynamicSharedMemorySize, LDS_BYTES) != hipSuccess) { fprintf(stderr, "kernel_launch: hipFuncSetAttribute failed\n"); grid = -1; return; }
        if (hipOccupancyMaxActiveBlocksPerMultiprocessor(&per_cu, (const void*)hymba_fwd, NWAVES * 64, LDS_BYTES) != hipSuccess || per_cu < 1) { fprintf(stderr, "kernel_launch: occupancy query says %d\n", per_cu); }
        (void)hipGetLastError();
        grid = cus;
    }
    if (grid < 0) return;
    if (hipMemsetAsync((char*)d_ws + WS_CTL, 0, CTL_ZERO_BYTES, stream) != hipSuccess) return;
    Args a{};
    for (int i = 0; i < 13; ++i) a.in[i] = d_in[i];
    a.out = (float*)d_out; a.ws = (unsigned char*)d_ws;
#if MK_PER_PHASE
    for (int p = 0; p < N_PHASES; ++p) { a.ph_lo = p; a.ph_hi = p + 1; hipLaunchKernelGGL(hymba_fwd, dim3(grid), dim3(NWAVES * 64), LDS_BYTES, stream, a); }
#else
    a.ph_lo = 0; a.ph_hi = N_PHASES;
    hipLaunchKernelGGL(hymba_fwd, dim3(grid), dim3(NWAVES * 64), LDS_BYTES, stream, a);
#endif
}
```
